# Optimizing an MI355X kernel written in HIP

```python
import math
import jax, jax.numpy as jnp
from jax import lax
import numpy as np

D_MODEL = 1024
BATCH = 8
SEQ = 4096
DEPTH = 4

CHUNK = 64
QBLK = 128
HEAD_DIM = 64
H_SB = 4
H_FOX = 4
H_DIFF = 4
W_SB = H_SB * HEAD_DIM
W_FOX = H_FOX * HEAD_DIM
W_DIFF_QK = H_DIFF * 2 * HEAD_DIM
DIFF_V_DIM = 2 * HEAD_DIM
W_DIFF = H_DIFF * DIFF_V_DIM
MIX_WIDTH = W_SB + W_FOX + W_DIFF
N_BRANCH = 3
ROT_DIM = HEAD_DIM // 4
ROPE_THETA = 500000.0
D_FF = 2816
P_DIM = 256
EPS = 1e-6
FORGET_BIAS_INIT = 2.0
IN_SIZES = (W_SB, W_SB, W_SB, W_FOX, W_FOX, W_FOX, H_FOX, W_DIFF_QK, W_DIFF_QK, W_DIFF, N_BRANCH * D_MODEL)
IN_COLS = 3 * W_SB + 3 * W_FOX + H_FOX + 2 * W_DIFF_QK + W_DIFF + N_BRANCH * D_MODEL

kernel_name = 'hybrid_sb_fox_diff_macaron_ple'


def rms_norm(x, gain):
    xf = x.astype(jnp.float32)
    y = xf * lax.rsqrt(jnp.mean(xf * xf, axis=-1, keepdims=True) + EPS)
    return (y * gain.astype(jnp.float32)).astype(x.dtype)


def swiglu_ffn(h, gain, wi, wo):
    a, g = jnp.split(rms_norm(h, gain) @ wi, 2, axis=-1)
    return (jax.nn.silu(a) * g) @ wo


def rope_tables(positions):
    inv_freq = ROPE_THETA ** (-jnp.arange(0, ROT_DIM, 2, dtype=jnp.float32) / ROT_DIM)
    ang = positions.astype(jnp.float32)[..., None] * inv_freq
    return jnp.cos(ang), jnp.sin(ang)


def apply_partial_rope(x, cos, sin):
    c = cos[:, :, None, None, :]
    s = sin[:, :, None, None, :]
    x1 = x[..., :ROT_DIM // 2].astype(jnp.float32)
    x2 = x[..., ROT_DIM // 2:ROT_DIM].astype(jnp.float32)
    rot = jnp.concatenate([x1 * c - x2 * s, x2 * c + x1 * s], axis=-1).astype(x.dtype)
    return jnp.concatenate([rot, x[..., ROT_DIM:]], axis=-1)


def to_heads(x, n_heads, d):
    b, s, _ = x.shape
    return x.reshape(b, s, n_heads, d).transpose(0, 2, 1, 3)


def from_heads(o):
    b, h, s, d = o.shape
    return o.transpose(0, 2, 1, 3).reshape(b, s, h * d)


def block_indices(i):
    lo, hi = i * QBLK, (i + 1) * QBLK
    t_idx = lo + jnp.arange(QBLK)[:, None]
    s_idx = jnp.arange(hi)[None, :]
    return lo, hi, t_idx, s_idx


def stick_breaking_attention(q, k, v):
    scale = HEAD_DIM ** -0.5
    outs = []
    for i in range(q.shape[2] // QBLK):
        lo, hi, t_idx, s_idx = block_indices(i)
        strict = s_idx < t_idx
        z = jnp.einsum('bhqd,bhkd->bhqk', q[:, :, lo:hi], k[:, :, :hi]).astype(jnp.float32) * scale
        log_beta = jax.nn.log_sigmoid(z)
        log_keep = jnp.where(strict, jax.nn.log_sigmoid(-z), 0.0)
        tail = lax.cumsum(log_keep, axis=3, reverse=True) - log_keep
        a = jnp.where(strict, jnp.exp(log_beta + tail), 0.0)
        outs.append(jnp.einsum('bhqk,bhkd->bhqd', a.astype(v.dtype), v[:, :, :hi]))
    return jnp.concatenate(outs, axis=2)


def forgetting_attention(q, k, v, log_f):
    scale = HEAD_DIM ** -0.5
    cum = jnp.cumsum(log_f, axis=-1)
    outs = []
    for i in range(q.shape[2] // QBLK):
        lo, hi, t_idx, s_idx = block_indices(i)
        logits = jnp.einsum('bhqd,bhkd->bhqk', q[:, :, lo:hi], k[:, :, :hi]).astype(jnp.float32) * scale
        logits = logits + cum[:, :, lo:hi, None] - cum[:, :, None, :hi]
        probs = jax.nn.softmax(jnp.where(s_idx <= t_idx, logits, -jnp.inf), axis=-1)
        outs.append(jnp.einsum('bhqk,bhkd->bhqd', probs.astype(v.dtype), v[:, :, :hi]))
    return jnp.concatenate(outs, axis=2)


def differential_attention(q1, q2, k1, k2, v, lam):
    scale = HEAD_DIM ** -0.5
    outs = []
    for i in range(q1.shape[2] // QBLK):
        lo, hi, t_idx, s_idx = block_indices(i)
        mask = (s_idx // CHUNK) <= (t_idx // CHUNK)
        s1 = jnp.einsum('bhqd,bhkd->bhqk', q1[:, :, lo:hi], k1[:, :, :hi]).astype(jnp.float32) * scale
        s2 = jnp.einsum('bhqd,bhkd->bhqk', q2[:, :, lo:hi], k2[:, :, :hi]).astype(jnp.float32) * scale
        a1 = jax.nn.softmax(jnp.where(mask, s1, -jnp.inf), axis=-1)
        a2 = jax.nn.softmax(jnp.where(mask, s2, -jnp.inf), axis=-1)
        w = a1 - lam * a2
        outs.append(jnp.einsum('bhqk,bhkd->bhqd', w.astype(v.dtype), v[:, :, :hi]))
    return jnp.concatenate(outs, axis=2)


def token_mixing(u, cos, sin, w_in, b_forget, qk_gain_fox, qk_gain_diff, diff_lambda, diff_subln, w_br, w_o, lam_init):
    b, s, _ = u.shape
    split_idx = np.cumsum(IN_SIZES)[:-1].tolist()
    qa, ka, va, qb, kb, vb, fb, qc, kc, vc, gates = jnp.split(u @ w_in, split_idx, axis=-1)

    oa = stick_breaking_attention(to_heads(qa, H_SB, HEAD_DIM), to_heads(ka, H_SB, HEAD_DIM), to_heads(va, H_SB, HEAD_DIM))

    qb = rms_norm(qb.reshape(b, s, H_FOX, HEAD_DIM), qk_gain_fox[0]).transpose(0, 2, 1, 3)
    kb = rms_norm(kb.reshape(b, s, H_FOX, HEAD_DIM), qk_gain_fox[1]).transpose(0, 2, 1, 3)
    log_f = jax.nn.log_sigmoid(fb.astype(jnp.float32) + b_forget.astype(jnp.float32)).transpose(0, 2, 1)
    ob = forgetting_attention(qb, kb, to_heads(vb, H_FOX, HEAD_DIM), log_f)

    qc = apply_partial_rope(rms_norm(qc.reshape(b, s, H_DIFF, 2, HEAD_DIM), qk_gain_diff[0]), cos, sin)
    kc = apply_partial_rope(rms_norm(kc.reshape(b, s, H_DIFF, 2, HEAD_DIM), qk_gain_diff[1]), cos, sin)
    q1, q2 = qc[:, :, :, 0].transpose(0, 2, 1, 3), qc[:, :, :, 1].transpose(0, 2, 1, 3)
    k1, k2 = kc[:, :, :, 0].transpose(0, 2, 1, 3), kc[:, :, :, 1].transpose(0, 2, 1, 3)
    lf = diff_lambda.astype(jnp.float32)
    lam = jnp.exp(jnp.sum(lf[0] * lf[1])) - jnp.exp(jnp.sum(lf[2] * lf[3])) + lam_init
    oc = differential_attention(q1, q2, k1, k2, to_heads(vc, H_DIFF, DIFF_V_DIM), lam)
    oc = rms_norm(oc, diff_subln) * (1.0 - lam_init)

    y_a = from_heads(oa) @ w_br[:W_SB]
    y_b = from_heads(ob) @ w_br[W_SB:W_SB + W_FOX]
    y_c = from_heads(oc) @ w_br[W_SB + W_FOX:]
    g = jax.nn.sigmoid(gates.reshape(b, s, N_BRANCH, D_MODEL))
    merged = g[:, :, 0] * y_a + g[:, :, 1] * y_b + g[:, :, 2] * y_c
    return merged @ w_o


def setup_inputs(seed: int = 0) -> dict:
    key = jax.random.key(seed)
    ks = jax.random.split(key, 24)

    def w(k, shape, fan_in, gain=1.0):
        return jax.random.normal(k, shape, jnp.float32) * (gain * fan_in ** -0.5)

    def gn(k, shape):
        return 1.0 + 0.05 * jax.random.normal(k, shape, jnp.float32)

    x = jax.random.normal(ks[0], (BATCH, SEQ, D_MODEL), jnp.float32)
    p = jax.random.normal(ks[1], (DEPTH, BATCH, SEQ, P_DIM), jnp.float32)
    start = jax.random.randint(ks[2], (BATCH, 1), 0, 8192, dtype=jnp.int32)
    positions = start + jnp.arange(SEQ, dtype=jnp.int32)[None, :]
    return {
        'x': x,
        'p': p,
        'positions': positions,
        'ffn1_norm': gn(ks[3], (DEPTH, D_MODEL)),
        'ffn1_wi': w(ks[4], (DEPTH, D_MODEL, 2 * D_FF), D_MODEL),
        'ffn1_wo': w(ks[5], (DEPTH, D_FF, D_MODEL), D_FF, 0.5),
        'mix_norm': gn(ks[6], (DEPTH, D_MODEL)),
        'w_in': w(ks[7], (DEPTH, D_MODEL, IN_COLS), D_MODEL),
        'b_forget': FORGET_BIAS_INIT + 0.1 * jax.random.normal(ks[8], (DEPTH, H_FOX), jnp.float32),
        'qk_gain_fox': gn(ks[9], (DEPTH, 2, HEAD_DIM)),
        'qk_gain_diff': gn(ks[10], (DEPTH, 2, HEAD_DIM)),
        'diff_lambda': 0.1 * jax.random.normal(ks[11], (DEPTH, 4, HEAD_DIM), jnp.float32),
        'diff_subln': gn(ks[12], (DEPTH, DIFF_V_DIM)),
        'w_br': w(ks[13], (DEPTH, MIX_WIDTH, D_MODEL), MIX_WIDTH),
        'w_o': w(ks[14], (DEPTH, D_MODEL, D_MODEL), D_MODEL, 0.5),
        'ffn2_norm': gn(ks[15], (DEPTH, D_MODEL)),
        'ffn2_wi': w(ks[16], (DEPTH, D_MODEL, 2 * D_FF), D_MODEL),
        'ffn2_wo': w(ks[17], (DEPTH, D_FF, D_MODEL), D_FF, 0.5),
        'ple_norm': gn(ks[18], (DEPTH, D_MODEL)),
        'ple_gate_w': w(ks[19], (DEPTH, D_MODEL, D_MODEL), D_MODEL),
        'ple_proj_w': w(ks[20], (DEPTH, P_DIM, D_MODEL), P_DIM, 0.5),
    }


def reference(x, p, positions, ffn1_norm, ffn1_wi, ffn1_wo, mix_norm, w_in, b_forget, qk_gain_fox, qk_gain_diff, diff_lambda, diff_subln, w_br, w_o, ffn2_norm, ffn2_wi, ffn2_wo, ple_norm, ple_gate_w, ple_proj_w):
    cos, sin = rope_tables(positions)
    h = x
    for i in range(DEPTH):
        lam_init = 0.8 - 0.6 * math.exp(-0.3 * i)
        h = h + 0.5 * swiglu_ffn(h, ffn1_norm[i], ffn1_wi[i], ffn1_wo[i])
        u = rms_norm(h, mix_norm[i])
        h = h + token_mixing(u, cos, sin, w_in[i], b_forget[i], qk_gain_fox[i], qk_gain_diff[i], diff_lambda[i], diff_subln[i], w_br[i], w_o[i], lam_init)
        h = h + 0.5 * swiglu_ffn(h, ffn2_norm[i], ffn2_wi[i], ffn2_wo[i])
        gate = jax.nn.sigmoid(rms_norm(h, ple_norm[i]) @ ple_gate_w[i])
        h = h + gate * (p[i] @ ple_proj_w[i])
    return h
```

```cpp
#include <hip/hip_runtime.h>
#include <hip/hip_cooperative_groups.h>
#include <cstdio>
#include <cstdint>
namespace cg = cooperative_groups;

#define LAS __attribute__((address_space(3)))
#define GAS __attribute__((address_space(1)))
typedef unsigned short bf16_t;
typedef short bf16x8 __attribute__((ext_vector_type(8)));
typedef short s16x4 __attribute__((ext_vector_type(4)));
typedef float f32x4 __attribute__((ext_vector_type(4)));
typedef float f32x16 __attribute__((ext_vector_type(16)));
typedef unsigned u32x4 __attribute__((ext_vector_type(4)));
typedef unsigned u32x2 __attribute__((ext_vector_type(2)));
typedef float f32x2_t __attribute__((ext_vector_type(2)));
typedef __bf16 bf16x2_t __attribute__((ext_vector_type(2)));

constexpr int MTOK = 32768, DM = 1024, SEQ = 4096, NBATCH = 8, DFF = 2816, NLAYER = 4, PDIM = 256;
constexpr int INCOLS = 6148, NQKV = 3072, NIN = 3328;
constexpr float EPS = 1e-6f, L2E = 1.4426950408889634f, C2 = 0.125f * 1.4426950408889634f;

constexpr size_t MiB = 1u << 20;
constexpr size_t WS_CTL = 0;
constexpr size_t WS_SS = 1 * MiB;
constexpr size_t WS_COS = 4 * MiB, WS_SIN = 5 * MiB, WS_LOGF = 6 * MiB;
constexpr size_t WS_W = 8 * MiB;
constexpr size_t LAYER_W_ELEMS = 27262976;
constexpr size_t OW_1I = 0, OW_1O = 5767168, OW_IN = 8650752, OW_G = 12058624, OW_BR = 15204352, OW_O = 16252928, OW_2I = 17301504, OW_2O = 23068672, OW_PG = 25952256, OW_PP = 27000832;
constexpr size_t WS_HB = 216 * MiB;
constexpr size_t WS_BIG = 280 * MiB;
constexpr size_t WS_GS = 472 * MiB;
constexpr size_t WS_AO = 536 * MiB;
constexpr size_t WS_LO = 600 * MiB;
constexpr size_t WS_END = 664 * MiB;
constexpr size_t WS_PB = WS_BIG + 176 * MiB;

constexpr int LDS_BYTES = 147456;

__device__ __forceinline__ unsigned cvtpk(float lo, float hi) { f32x2_t v = {lo, hi}; bf16x2_t b = __builtin_convertvector(v, bf16x2_t); return __builtin_bit_cast(unsigned, b); }
__device__ __forceinline__ u32x4 pack8(f32x4 a, f32x4 b) { u32x4 w; w.x = cvtpk(a[0], a[1]); w.y = cvtpk(a[2], a[3]); w.z = cvtpk(b[0], b[1]); w.w = cvtpk(b[2], b[3]); return w; }
__device__ __forceinline__ void unpack8(u32x4 w, f32x4& a, f32x4& b) {
    a[0] = __uint_as_float(w.x << 16); a[1] = __uint_as_float(w.x & 0xffff0000u); a[2] = __uint_as_float(w.y << 16); a[3] = __uint_as_float(w.y & 0xffff0000u);
    b[0] = __uint_as_float(w.z << 16); b[1] = __uint_as_float(w.z & 0xffff0000u); b[2] = __uint_as_float(w.w << 16); b[3] = __uint_as_float(w.w & 0xffff0000u); }
__device__ __forceinline__ float fsigmoid(float x) { return __builtin_amdgcn_rcpf(1.0f + __builtin_amdgcn_exp2f(-x * L2E)); }
__device__ __forceinline__ f32x4 sig4(f32x4 x) { f32x4 r; r[0] = fsigmoid(x[0]); r[1] = fsigmoid(x[1]); r[2] = fsigmoid(x[2]); r[3] = fsigmoid(x[3]); return r; }
__device__ __forceinline__ float dot4(f32x4 a) { return (a[0] * a[0] + a[1] * a[1]) + (a[2] * a[2] + a[3] * a[3]); }

namespace pg8 {
constexpr int BM = 256, BK = 64, HALF = 128, HTB = HALF * BK * 2, STAGE_BYTES = 8 * HTB, NXCD = 8, WGM = 8;
__host__ __device__ __forceinline__ int lds_byte(int r, int c) { const int st = (r >> 4) * 2 + (c >> 5), rr = r & 15, cc = c & 31, ob = rr * 64 + cc * 2; return st * 1024 + (ob ^ (((ob >> 9) & 1) << 5)); }
__host__ __device__ __forceinline__ void stage_rc(int b, int& R, int& C) { const int st = b / 1024, sb = b % 1024, swz = sb ^ (((sb >> 9) & 1) << 5); R = (st >> 1) * 16 + swz / 64; C = (st & 1) * 32 + (swz % 64) / 2; }
__host__ __device__ __forceinline__ int perm32(int rho) { const int n = rho >> 4, i = rho & 15; return 8 * (i >> 2) + 4 * n + (i & 3); }

struct Unit { int pm, pn; };
struct Gemm { const bf16_t* A; const bf16_t* Bt; int lda, ldb, M, N, K; };

struct StaticOrder {
    int nM, nN, nwg, G, c;
    __host__ __device__ void init(int M, int N, int G_, int c_) { nM = M / BM; nN = N / BM; nwg = nM * nN; G = G_; c = c_; }
    __host__ __device__ bool next(int i, Unit& u) const {
        const long L = (long)i * G + c; if (L >= nwg) return false;
        int wgid = (int)L; { const int q = nwg / NXCD, r = nwg % NXCD, xcd = wgid % NXCD, off = wgid / NXCD; wgid = (xcd < r ? xcd * (q + 1) : r * (q + 1) + (xcd - r) * q) + off; }
        const int nig = WGM * nN, gid = wgid / nig, fm = gid * WGM, gsz = (nM - fm) < WGM ? (nM - fm) : WGM;
        u.pm = fm + ((wgid % nig) % gsz); u.pn = (wgid % nig) / gsz; return true;
    }
};

enum { EM_SWIGLU = 0, EM_RES = 1, EM_QKV = 2, EM_GATE = 3, EM_MERGE = 4, EM_STORE = 5, EM_PLE = 6 };
struct Epi {
    static constexpr bool PERM = true;
    int mode; int flag; float scale;
    const GAS float* ssq_in; GAS float* ssq_out; GAS float* h; GAS bf16_t* o16; GAS float* mf; const GAS bf16_t* g16;
    const GAS bf16_t* hin; GAS bf16_t* lo; int fin;
    const GAS float *gfox, *gdiff, *cosT, *sinT, *bfg; GAS float* logf;

    __device__ __forceinline__ void operator()(const f32x4 (&acc)[2][2][4][2], const Unit& u, int wr, int wc, int fr, int fq) const {
        const int rowb = u.pm * BM + wr * 64 + fr;
        float rsv[2][4];
#pragma unroll
        for (int ai = 0; ai < 2; ++ai)
#pragma unroll
            for (int m = 0; m < 4; ++m) rsv[ai][m] = ssq_in[rowb + ai * HALF + m * 16];
        if (mode == EM_SWIGLU) {
            const int colh = u.pn * 128 + wc * 32 + fq * 8;
#pragma unroll
            for (int ai = 0; ai < 2; ++ai)
#pragma unroll
                for (int m = 0; m < 4; ++m) {
                    const int row = rowb + ai * HALF + m * 16;
                    const float rstd = __builtin_amdgcn_rsqf(rsv[ai][m] * (1.0f / DM) + EPS);
                    f32x4 o[2];
#pragma unroll
                    for (int n = 0; n < 2; ++n) { const f32x4 a = acc[ai][0][m][n] * rstd, g = acc[ai][1][m][n] * rstd; o[n] = a * sig4(a) * g; }
                    *(GAS u32x4*)(o16 + (size_t)row * DFF + colh) = pack8(o[0], o[1]);
                }
        } else if (mode == EM_RES || mode == EM_PLE) {
#pragma unroll
            for (int ai = 0; ai < 2; ++ai)
#pragma unroll
                for (int m = 0; m < 4; ++m) {
                    const int row = rowb + ai * HALF + m * 16;
                    float rstd = 1.f; if (mode == EM_PLE) rstd = __builtin_amdgcn_rsqf(rsv[ai][m] * (1.0f / DM) + EPS);
                    float ss = 0.f;
#pragma unroll
                    for (int bj = 0; bj < 2; ++bj) {
                        const size_t off = (size_t)row * DM + u.pn * BM + bj * HALF + wc * 32 + fq * 8;
                        f32x4 h0, h1, l0, l1; unpack8(*(const GAS u32x4*)(hin + off), h0, h1); unpack8(*(const GAS u32x4*)(lo + off), l0, l1);
                        h0 += l0; h1 += l1;
                        if (mode == EM_PLE) { f32x4 t0, t1; unpack8(*(const GAS u32x4*)(g16 + off), t0, t1);
                            h0 += sig4(acc[ai][bj][m][0] * rstd) * t0; h1 += sig4(acc[ai][bj][m][1] * rstd) * t1; }
                        else { h0 += acc[ai][bj][m][0] * scale; h1 += acc[ai][bj][m][1] * scale; }
                        if (fin) { *(GAS f32x4*)(h + off) = h0; *(GAS f32x4*)(h + off + 4) = h1; }
                        const u32x4 hw = pack8(h0, h1); f32x4 g0, g1; unpack8(hw, g0, g1);
                        *(GAS u32x4*)(o16 + off) = hw;
                        *(GAS u32x4*)(lo + off) = pack8(h0 - g0, h1 - g1);
                        ss += dot4(h0) + dot4(h1);
                    }
                    ss += __shfl_xor(ss, 16); ss += __shfl_xor(ss, 32);
                    if (fq == 0) (void)__hip_atomic_fetch_add(ssq_out + row, ss, __ATOMIC_RELAXED, __HIP_MEMORY_SCOPE_AGENT);
                }
        } else if (mode == EM_QKV) {
            const int T = u.pn;
            if (T == 12) {
                if (wc == 0 && fq == 0) {
                    const f32x4 bf = *(const GAS f32x4*)bfg;
#pragma unroll
                    for (int ai = 0; ai < 2; ++ai)
#pragma unroll
                        for (int m = 0; m < 4; ++m) {
                            const int row = rowb + ai * HALF + m * 16;
                            const float rstd = __builtin_amdgcn_rsqf(rsv[ai][m] * (1.0f / DM) + EPS);
                            const f32x4 v = acc[ai][0][m][0] * rstd + bf; f32x4 o;
#pragma unroll
                            for (int i = 0; i < 4; ++i) o[i] = (fminf(v[i], 0.f) * L2E - __builtin_amdgcn_logf(1.0f + __builtin_amdgcn_exp2f(-fabsf(v[i]) * L2E)));
                            *(GAS f32x4*)(logf + (size_t)row * 4) = o;
                        }
                }
                return;
            }
            const bool do_norm = (T == 3 || T == 4 || (T >= 6 && T <= 9)), do_rope = (T >= 6 && T <= 9);
            const GAS float* gain = (T == 3) ? gfox : (T == 4) ? gfox + 64 : (T == 6 || T == 7) ? gdiff : gdiff + 64;
            const float sc = (T == 0 || T == 3 || T == 6 || T == 7) ? C2 : 1.0f;
            f32x4 gv[2][2];
#pragma unroll
            for (int bj = 0; bj < 2; ++bj)
#pragma unroll
                for (int n = 0; n < 2; ++n) gv[bj][n] = do_norm ? *(const GAS f32x4*)(gain + 32 * bj + 8 * fq + 4 * n) : (f32x4){1.f, 1.f, 1.f, 1.f};
#pragma unroll
            for (int ai = 0; ai < 2; ++ai)
#pragma unroll
                for (int m = 0; m < 4; ++m) {
                    const int row = rowb + ai * HALF + m * 16;
                    const float rstd = __builtin_amdgcn_rsqf(rsv[ai][m] * (1.0f / DM) + EPS);
                    f32x4 x[2][2];
#pragma unroll
                    for (int bj = 0; bj < 2; ++bj)
#pragma unroll
                        for (int n = 0; n < 2; ++n) x[bj][n] = acc[ai][bj][m][n] * rstd;
                    if (do_norm) {
                        float ss = (dot4(x[0][0]) + dot4(x[0][1])) + (dot4(x[1][0]) + dot4(x[1][1]));
                        ss += __shfl_xor(ss, 16); ss += __shfl_xor(ss, 32);
                        const float rn = __builtin_amdgcn_rsqf(ss * (1.0f / 64.0f) + EPS);
#pragma unroll
                        for (int bj = 0; bj < 2; ++bj)
#pragma unroll
                            for (int n = 0; n < 2; ++n) x[bj][n] = x[bj][n] * rn * gv[bj][n];
                    }
                    if (do_rope) {
#pragma unroll
                        for (int n = 0; n < 2; ++n) {
                            f32x4 pr; pr[0] = __shfl_xor(x[0][n][0], 16); pr[1] = __shfl_xor(x[0][n][1], 16); pr[2] = __shfl_xor(x[0][n][2], 16); pr[3] = __shfl_xor(x[0][n][3], 16);
                            const f32x4 c = *(const GAS f32x4*)(cosT + (size_t)row * 8 + 4 * n), s = *(const GAS f32x4*)(sinT + (size_t)row * 8 + 4 * n);
                            if (fq == 0) x[0][n] = x[0][n] * c - pr * s; else if (fq == 1) x[0][n] = x[0][n] * c + pr * s;
                        }
                    }
#pragma unroll
                    for (int bj = 0; bj < 2; ++bj)
                        *(GAS u32x4*)(o16 + (size_t)row * NQKV + T * 256 + wc * 64 + bj * 32 + fq * 8) = pack8(x[bj][0] * sc, x[bj][1] * sc);
                }
        } else {
#pragma unroll
            for (int ai = 0; ai < 2; ++ai)
#pragma unroll
                for (int m = 0; m < 4; ++m) {
                    const int row = rowb + ai * HALF + m * 16;
                    float rstd = 1.f; if (mode == EM_GATE) rstd = __builtin_amdgcn_rsqf(rsv[ai][m] * (1.0f / DM) + EPS);
#pragma unroll
                    for (int bj = 0; bj < 2; ++bj) {
                        const size_t off = (size_t)row * DM + u.pn * BM + bj * HALF + wc * 32 + fq * 8;
                        if (mode == EM_GATE) { *(GAS u32x4*)(o16 + off) = pack8(sig4(acc[ai][bj][m][0] * rstd), sig4(acc[ai][bj][m][1] * rstd)); }
                        else if (mode == EM_STORE) { *(GAS u32x4*)(o16 + off) = pack8(acc[ai][bj][m][0], acc[ai][bj][m][1]); }
                        else {
                            f32x4 g0, g1; unpack8(*(const GAS u32x4*)(g16 + off), g0, g1);
                            f32x4 v0 = g0 * acc[ai][bj][m][0], v1 = g1 * acc[ai][bj][m][1];
                            GAS bf16_t* mf16 = (GAS bf16_t*)mf;
                            if (flag > 0) { f32x4 a0, a1; unpack8(*(const GAS u32x4*)(mf16 + off), a0, a1); v0 += a0; v1 += a1; }
                            if (flag < 2) *(GAS u32x4*)(mf16 + off) = pack8(v0, v1);
                            else *(GAS u32x4*)(o16 + off) = pack8(v0, v1);
                        }
                    }
                }
        }
    }
};

__device__ __forceinline__ void gemm_phase(LAS unsigned char* lds, const Gemm g, const StaticOrder& S, const Epi& E) {
    int tid_ = threadIdx.x; asm volatile("" : "+v"(tid_));
    const int tid = tid_, wid = __builtin_amdgcn_readfirstlane(tid >> 6), lane = tid & 63, wr = wid >> 2, wc = wid & 3, fr = lane & 15, fq = lane >> 4;
    const int K = g.K, nt = K / BK;
    unsigned voffA[2], voffB[2];
#pragma unroll
    for (int i = 0; i < 2; ++i) { int R, C; stage_rc(tid * 16 + i * 8192, R, C); const int Rb = ((R & ~31) + perm32(R & 31));
        voffA[i] = (unsigned)(R * g.lda + C) * 2u; voffB[i] = (unsigned)(Rb * g.ldb + C) * 2u; }
    const size_t kstep = (size_t)(BK * 2);
    const size_t hstepA = (size_t)HALF * g.lda * 2, hstepB = (size_t)HALF * g.ldb * 2;
    const size_t tstepA = 2 * hstepA, tstepB = 2 * hstepB;
    const unsigned ldsw = (unsigned)wid * 1024u;
    const int aoff = lds_byte(wr * 64 + fr, fq * 8), boff = lds_byte(wc * 32 + fr, fq * 8);
#define PG8_SA(b, h) (((b) * 2 + (h)) * HTB)
#define PG8_SB(b, h) ((4 + (b) * 2 + (h)) * HTB)
#define PG8_STAGE(bufoff, gbase, voff) do { _Pragma("unroll") for (int _i = 0; _i < 2; ++_i) \
        __builtin_amdgcn_global_load_lds((const unsigned*)((const char*)(gbase) + (voff)[_i]), (LAS unsigned*)(lds + (bufoff) + ldsw + _i * 8192), 16, 0, 0); } while (0)
#define PG8_LDA(dst, b, h) do { _Pragma("unroll") for (int m = 0; m < 4; ++m) _Pragma("unroll") for (int k = 0; k < 2; ++k) dst[m][k] = *(const LAS bf16x8*)(lds + PG8_SA(b, h) + aoff + m * 2048 + k * 1024); } while (0)
#define PG8_LDB(dst, b, h) do { _Pragma("unroll") for (int n = 0; n < 2; ++n) _Pragma("unroll") for (int k = 0; k < 2; ++k) dst[n][k] = *(const LAS bf16x8*)(lds + PG8_SB(b, h) + boff + n * 2048 + k * 1024); } while (0)
#define PG8_MMA(ai, bj, At, Bt) do { __builtin_amdgcn_s_setprio(1); _Pragma("unroll") for (int m = 0; m < 4; ++m) _Pragma("unroll") for (int n = 0; n < 2; ++n) _Pragma("unroll") for (int k = 0; k < 2; ++k) \
        acc[ai][bj][m][n] = __builtin_amdgcn_mfma_f32_16x16x32_bf16(Bt[n][k], At[m][k], acc[ai][bj][m][n], 0, 0, 0); __builtin_amdgcn_s_setprio(0); } while (0)
#define PG8_WAIT_V(n) asm volatile("s_waitcnt vmcnt(" #n ")" ::: "memory")
#define PG8_WAIT_L(n) asm volatile("s_waitcnt lgkmcnt(" #n ")" ::: "memory")
#define PG8_BAR __builtin_amdgcn_s_barrier()
#define PG8_SCHED __builtin_amdgcn_sched_barrier(0)
    Unit cur, nxt; int ui = 0;
    if (!S.next(0, cur)) return;
    f32x4 acc[2][2][4][2];
#pragma unroll
    for (int a = 0; a < 2; ++a)
#pragma unroll
        for (int b = 0; b < 2; ++b)
#pragma unroll
            for (int m = 0; m < 4; ++m)
#pragma unroll
                for (int n = 0; n < 2; ++n) acc[a][b][m][n] = (f32x4){0.f, 0.f, 0.f, 0.f};
    bf16x8 At[4][2], B0[2][2], B1[2][2];
    const char* cA = (const char*)g.A + (size_t)cur.pm * tstepA; const char* cB = (const char*)g.Bt + (size_t)cur.pn * tstepB;
    PG8_STAGE(PG8_SB(0, 0), cB, voffB); PG8_STAGE(PG8_SB(0, 1), cB + hstepB, voffB); PG8_STAGE(PG8_SA(0, 0), cA, voffA); PG8_STAGE(PG8_SA(0, 1), cA + hstepA, voffA);
    if (wr == 1) PG8_BAR;
    PG8_WAIT_V(2); PG8_BAR;
    PG8_STAGE(PG8_SB(1, 0), cB + kstep, voffB); PG8_STAGE(PG8_SA(1, 0), cA + kstep, voffA); PG8_STAGE(PG8_SB(1, 1), cB + hstepB + kstep, voffB);
    PG8_WAIT_V(6); PG8_BAR;
    for (;;) {
        const bool has_next = S.next(ui + 1, nxt);
        const char* nA = has_next ? (const char*)g.A + (size_t)nxt.pm * tstepA : cA; const char* nB = has_next ? (const char*)g.Bt + (size_t)nxt.pn * tstepB : cB;
        for (int t = 0; t < nt; t += 2) {
            const bool last = (t == nt - 2);
            const char* a1 = cA + (size_t)(t + 1) * kstep;
            const char* a2 = last ? nA : cA + (size_t)(t + 2) * kstep; const char* b2 = last ? nB : cB + (size_t)(t + 2) * kstep;
            const char* a3 = a2 + kstep; const char* b3 = b2 + kstep;
            PG8_LDB(B0, 0, 0); PG8_LDB(B1, 0, 1); PG8_SCHED; PG8_LDA(At, 0, 0); PG8_STAGE(PG8_SA(1, 1), a1 + hstepA, voffA);
            PG8_WAIT_V(8); PG8_WAIT_L(0); PG8_BAR; PG8_MMA(0, 0, At, B0); PG8_MMA(0, 1, At, B1); PG8_BAR; PG8_SCHED;
            PG8_LDA(At, 0, 1); PG8_STAGE(PG8_SB(0, 0), b2, voffB); PG8_STAGE(PG8_SB(0, 1), b2 + hstepB, voffB); PG8_STAGE(PG8_SA(0, 0), a2, voffA);
            PG8_WAIT_V(8); PG8_WAIT_L(0); PG8_BAR; PG8_MMA(1, 0, At, B0); PG8_MMA(1, 1, At, B1); PG8_BAR; PG8_SCHED;
            PG8_LDB(B0, 1, 0); PG8_LDB(B1, 1, 1); PG8_SCHED; PG8_LDA(At, 1, 0); PG8_STAGE(PG8_SA(0, 1), a2 + hstepA, voffA);
            PG8_WAIT_V(8); PG8_WAIT_L(0); PG8_BAR; PG8_MMA(0, 0, At, B0); PG8_MMA(0, 1, At, B1); PG8_BAR; PG8_SCHED;
            PG8_LDA(At, 1, 1); PG8_STAGE(PG8_SB(1, 0), b3, voffB); PG8_STAGE(PG8_SB(1, 1), b3 + hstepB, voffB); PG8_STAGE(PG8_SA(1, 0), a3, voffA);
            PG8_WAIT_V(8); PG8_WAIT_L(0); PG8_BAR; PG8_MMA(1, 0, At, B0); PG8_MMA(1, 1, At, B1); PG8_BAR; PG8_SCHED;
        }
        if (wr == 0) PG8_BAR;
        E(acc, cur, wr, wc, fr, fq);
        if (!has_next) break;
#pragma unroll
        for (int a = 0; a < 2; ++a)
#pragma unroll
            for (int b = 0; b < 2; ++b)
#pragma unroll
                for (int m = 0; m < 4; ++m)
#pragma unroll
                    for (int n = 0; n < 2; ++n) acc[a][b][m][n] = (f32x4){0.f, 0.f, 0.f, 0.f};
        cur = nxt; cA = nA; cB = nB; ++ui;
        if (wr == 1) PG8_BAR;
    }
    PG8_WAIT_V(0);
    PG8_BAR;
#undef PG8_SA
#undef PG8_SB
#undef PG8_STAGE
#undef PG8_LDA
#undef PG8_LDB
#undef PG8_MMA
#undef PG8_WAIT_V
#undef PG8_WAIT_L
#undef PG8_BAR
#undef PG8_SCHED
}
}

namespace att {
constexpr int PITCH = NQKV, AOP = DM;
constexpr int LK = 0, LV = 16384, LWS = 65536, LOST = 67584, LCUM = LOST + 32768, LMISC = 133120;
__device__ __forceinline__ int crow(int r, int hi) { return (r & 3) + 8 * (r >> 2) + 4 * hi; }
__device__ __forceinline__ float partner32(float x, int hi) { auto rr = __builtin_amdgcn_permlane32_swap(__float_as_uint(x), __float_as_uint(x), false, false); return __uint_as_float(hi ? rr[0] : rr[1]); }
__device__ __forceinline__ float rowmax(const f32x16& p0, const f32x16& p1) {
    float a = fmaxf(fmaxf(p0[0], p0[1]), p1[0]), b = fmaxf(fmaxf(p0[2], p0[3]), p1[1]); a = fmaxf(fmaxf(a, p1[2]), p1[3]);
#pragma unroll
    for (int r = 4; r < 16; r += 4) { a = fmaxf(fmaxf(a, p0[r]), p0[r + 1]); b = fmaxf(fmaxf(b, p0[r + 2]), p0[r + 3]); a = fmaxf(fmaxf(a, p1[r]), p1[r + 1]); b = fmaxf(fmaxf(b, p1[r + 2]), p1[r + 3]); }
    const float m = fmaxf(a, b);
    auto rr = __builtin_amdgcn_permlane32_swap(__float_as_uint(m), __float_as_uint(m), false, false);
    return fmaxf(__uint_as_float(rr[0]), __uint_as_float(rr[1]));
}
__device__ __forceinline__ void qkt(f32x16& p0, f32x16& p1, const LAS char* kb, const bf16x8* qr, const f32x16& cinit) {
#pragma unroll
    for (int d0 = 0; d0 < 4; ++d0) {
        const bf16x8 b0 = *(const LAS bf16x8*)(kb + d0 * 2048);
        const bf16x8 b1 = *(const LAS bf16x8*)(kb + d0 * 2048 + 512);
        if (d0 == 0) { p0 = __builtin_amdgcn_mfma_f32_32x32x16_bf16(b0, qr[0], cinit, 0, 0, 0); p1 = __builtin_amdgcn_mfma_f32_32x32x16_bf16(b1, qr[0], cinit, 0, 0, 0); }
        else { p0 = __builtin_amdgcn_mfma_f32_32x32x16_bf16(b0, qr[d0], p0, 0, 0, 0); p1 = __builtin_amdgcn_mfma_f32_32x32x16_bf16(b1, qr[d0], p1, 0, 0, 0); }
    }
}
__device__ __forceinline__ void pv(f32x16* o, int vb, bf16x8 pa0, bf16x8 pa1, bf16x8 pa2, bf16x8 pa3) {
    s16x4 lo[2][4], hi[2][4];
#pragma unroll
    for (int d0 = 0; d0 < 2; ++d0)
#pragma unroll
        for (int ks = 0; ks < 4; ++ks) {
            asm volatile("ds_read_b64_tr_b16 %0,%1 offset:%c2" : "=&v"(lo[d0][ks]) : "v"(vb), "i"(d0 * 4096 + ks * 1024) : "memory");
            asm volatile("ds_read_b64_tr_b16 %0,%1 offset:%c2" : "=&v"(hi[d0][ks]) : "v"(vb), "i"(d0 * 4096 + ks * 1024 + 512) : "memory"); }
    asm volatile("s_waitcnt lgkmcnt(0)" ::: "memory"); __builtin_amdgcn_sched_barrier(0);
#define PK(d, k) (bf16x8){lo[d][k][0], lo[d][k][1], lo[d][k][2], lo[d][k][3], hi[d][k][0], hi[d][k][1], hi[d][k][2], hi[d][k][3]}
    o[0] = __builtin_amdgcn_mfma_f32_32x32x16_bf16(pa0, PK(0, 0), o[0], 0, 0, 0); o[1] = __builtin_amdgcn_mfma_f32_32x32x16_bf16(pa0, PK(1, 0), o[1], 0, 0, 0);
    o[0] = __builtin_amdgcn_mfma_f32_32x32x16_bf16(pa1, PK(0, 1), o[0], 0, 0, 0); o[1] = __builtin_amdgcn_mfma_f32_32x32x16_bf16(pa1, PK(1, 1), o[1], 0, 0, 0);
    o[0] = __builtin_amdgcn_mfma_f32_32x32x16_bf16(pa2, PK(0, 2), o[0], 0, 0, 0); o[1] = __builtin_amdgcn_mfma_f32_32x32x16_bf16(pa2, PK(1, 2), o[1], 0, 0, 0);
    o[0] = __builtin_amdgcn_mfma_f32_32x32x16_bf16(pa3, PK(0, 3), o[0], 0, 0, 0); o[1] = __builtin_amdgcn_mfma_f32_32x32x16_bf16(pa3, PK(1, 3), o[1], 0, 0, 0);
#undef PK
}

template <int MODE, bool NOMAX = false>
__device__ __forceinline__ void attn_unit(int b, int h, int qb, const GAS bf16_t* __restrict__ QKV, GAS bf16_t* __restrict__ AO, const GAS float* __restrict__ logf,
                                          const GAS float* __restrict__ subln, float lam, float oscale, LAS unsigned char* shm) {
    constexpr int DV = (MODE == 2) ? 128 : 64, NPASS = (MODE == 2) ? 2 : 1, ND = DV / 32;
    int tid_ = threadIdx.x; asm volatile("" : "+v"(tid_));
    const int tid = tid_, lane = tid & 63, r32 = lane & 31, hi = lane >> 5; const int wid = __builtin_amdgcn_readfirstlane(tid >> 6);
    const long rowbase = (long)b * SEQ; const int q0 = qb * 256;
    const int qcol = MODE == 0 ? h * 64 : MODE == 1 ? 768 + h * 64 : 1536 + h * 128;
    const int kcol = MODE == 0 ? 256 + h * 64 : MODE == 1 ? 1024 + h * 64 : 2048 + h * 128;
    const int vcol = MODE == 0 ? 512 + h * 64 : MODE == 1 ? 1280 + h * 64 : 2560 + h * 128;
    const int ocol = MODE == 0 ? h * 64 : MODE == 1 ? 256 + h * 64 : 512 + h * 128;
    const int NT = 4 * qb + 4, ktmax_w = 4 * qb + (wid >> 1);
    const unsigned lds0 = (unsigned)(uintptr_t)shm;
    LAS float* wsf = (LAS float*)(shm + LWS) + wid * 64;
    LAS float* cum = (LAS float*)(shm + LCUM);
    const int trel = 32 * (wid & 1) + r32;
    float cq = 0.f; int it0 = 0;
    if (MODE == 1) {
        const int n = q0 + 256, base = tid * 8; float v[8];
#pragma unroll
        for (int i = 0; i < 8; ++i) { const int s = base + i; v[i] = (s < n) ? logf[(size_t)(rowbase + s) * 4 + h] : 0.f; }
#pragma unroll
        for (int i = 1; i < 8; ++i) v[i] += v[i - 1];
        float inc = v[7];
#pragma unroll
        for (int o = 1; o < 64; o <<= 1) { const float t = __shfl_up(inc, o); if (lane >= o) inc += t; }
        LAS float* wt = (LAS float*)(shm + LMISC) + 16;
        if (lane == 63) wt[wid] = inc;
        __syncthreads();
        float woff = 0.f;
#pragma unroll
        for (int w = 0; w < 8; ++w) woff += (w < wid) ? wt[w] : 0.f;
        const float toff = woff + inc - v[7];
#pragma unroll
        for (int i = 0; i < 8; ++i) cum[base + i] = v[i] + toff;
        __syncthreads();
        cq = cum[q0 + wid * 32 + r32];
        float gq = fabsf(subln[lane]), gk = fabsf(subln[64 + lane]);
#pragma unroll
        for (int o = 1; o < 64; o <<= 1) { gq = fmaxf(gq, __shfl_xor(gq, o)); gk = fmaxf(gk, __shfl_xor(gk, o)); }
        const float Bb = 64.0f * C2 * gq * gk * 1.03f + 1.0f, thr = -(2.0f * Bb + 150.0f), c0 = cum[q0];
        while (it0 < NT - 4 && (c0 - cum[64 * it0 + 63]) < thr) ++it0;
        it0 = __builtin_amdgcn_readfirstlane(it0);
    }
    GAS bf16_t* Ow = AO + (size_t)(rowbase + q0 + wid * 32) * AOP + ocol;
    LAS bf16_t* stg = (LAS bf16_t*)(shm + LOST) + wid * (DV * 32);
#pragma unroll
    for (int pass = 0; pass < NPASS; ++pass) {
        const GAS bf16_t* Qw = QKV + (size_t)(rowbase + q0 + wid * 32) * PITCH + qcol + pass * 64;
        const GAS bf16_t* ksrc = QKV + (size_t)(rowbase + lane) * PITCH + kcol + pass * 64 + wid * 8;
        const GAS bf16_t* vsrc = QKV + (size_t)(rowbase + 16 * (wid & 3) + (lane >> 2)) * PITCH + vcol + (wid >> 2) * 32 + (lane & 3) * 8;
        bf16x8 qr[4];
#pragma unroll
        for (int d0 = 0; d0 < 4; ++d0) qr[d0] = *(const GAS bf16x8*)(Qw + (size_t)r32 * PITCH + d0 * 16 + hi * 8);
        float mhat = 0.f, l_reg = 0.f, carry = 0.f;
        f32x16 o[ND];
#pragma unroll
        for (int d = 0; d < ND; ++d) o[d] = f32x16{};
        u32x4 kreg, vreg0, vreg1 = u32x4{};
        { const int kt = (MODE == 0) ? NT - 1 : it0; const size_t go = (size_t)kt * 64 * PITCH;
          kreg = *(const GAS u32x4*)(ksrc + go); vreg0 = *(const GAS u32x4*)(vsrc + go); if (DV == 128) vreg1 = *(const GAS u32x4*)(vsrc + go + 64); }
        u32x4 pw0 = u32x4{}, pw1 = u32x4{}, pw2 = u32x4{}, pw3 = u32x4{};
        const bool lag = (wid >= 4); bool pend = false; int vs = 0, vsp = 0;
        const int vbl = (int)(lds0 + LV) + ((lane >> 4) & 1) * 32 + (lane & 3) * 8 + (4 * hi + ((lane & 15) >> 2)) * 64;
#define ATT_PV(VB_) do { pv(o, (VB_), __builtin_bit_cast(bf16x8, pw0), __builtin_bit_cast(bf16x8, pw1), __builtin_bit_cast(bf16x8, pw2), __builtin_bit_cast(bf16x8, pw3)); \
            if (DV == 128) pv(o + 2, (VB_) + 8192, __builtin_bit_cast(bf16x8, pw0), __builtin_bit_cast(bf16x8, pw1), __builtin_bit_cast(bf16x8, pw2), __builtin_bit_cast(bf16x8, pw3)); } while (0)
        {   *(LAS u32x4*)(shm + LK + (it0 & 1) * 8192 + wid * 1024 + lane * 16) = kreg;
            *(LAS u32x4*)(shm + LV + wid * 1024 + lane * 16) = vreg0;
            if (DV == 128) *(LAS u32x4*)(shm + LV + 8192 + wid * 1024 + lane * 16) = vreg1;
            const int kt1 = (MODE == 0) ? NT - 2 - it0 : it0 + 1; const size_t go = (size_t)kt1 * 64 * PITCH;
            kreg = *(const GAS u32x4*)(ksrc + go); vreg0 = *(const GAS u32x4*)(vsrc + go); if (DV == 128) vreg1 = *(const GAS u32x4*)(vsrc + go + 64); }
        for (int it = it0; it < NT; ++it) {
            const int kt = (MODE == 0) ? NT - 1 - it : it, slot = it & 1;
            const int vsn = (vs == 2) ? 0 : vs + 1;
            __syncthreads();
            if (it + 1 < NT) {
                *(LAS u32x4*)(shm + LK + (slot ^ 1) * 8192 + wid * 1024 + lane * 16) = kreg;
                *(LAS u32x4*)(shm + LV + vsn * 16384 + wid * 1024 + lane * 16) = vreg0;
                if (DV == 128) *(LAS u32x4*)(shm + LV + vsn * 16384 + 8192 + wid * 1024 + lane * 16) = vreg1; }
            if (it + 2 < NT) { const int ktn = (MODE == 0) ? kt - 2 : kt + 2; const size_t go = (size_t)ktn * 64 * PITCH;
                kreg = *(const GAS u32x4*)(ksrc + go); vreg0 = *(const GAS u32x4*)(vsrc + go); if (DV == 128) vreg1 = *(const GAS u32x4*)(vsrc + go + 64); }
            if (lag && pend) { ATT_PV(vbl + vsp * 16384); pend = false; }
            bool wdone = false;
            if (kt <= ktmax_w) {
                const LAS char* kb = (const LAS char*)(shm + LK + slot * 8192) + hi * 1024 + r32 * 16;
                const bool diag = (kt == ktmax_w);
                f32x16 p0, p1;
                if (MODE == 0) {
                    f32x16 cz = f32x16{}; asm volatile("" : "+v"(cz));
                    qkt(p0, p1, kb, qr, cz);
                    f32x16 L0, L1;
#pragma unroll
                    for (int r = 0; r < 16; ++r) {
                        const float z0 = p0[r], z1 = p1[r];
                        L0[r] = -__builtin_amdgcn_logf(1.0f + __builtin_amdgcn_exp2f(-z0)) - z0;
                        L1[r] = -__builtin_amdgcn_logf(1.0f + __builtin_amdgcn_exp2f(-z1)) - z1;
                    }
                    if (diag) {
#pragma unroll
                        for (int r = 0; r < 16; ++r) { const int kv = crow(r, hi);
                            if (kv >= trel) { L0[r] = 0.f; p0[r] = -INFINITY; }
                            if (kv + 32 >= trel) { L1[r] = 0.f; p1[r] = -INFINITY; } }
                    }
                    float T0[4], T1[4], PG0[4], PG1[4];
#pragma unroll
                    for (int g = 0; g < 4; ++g) {
                        const float g0 = (L0[4 * g] + L0[4 * g + 1]) + (L0[4 * g + 2] + L0[4 * g + 3]), g1 = (L1[4 * g] + L1[4 * g + 1]) + (L1[4 * g + 2] + L1[4 * g + 3]);
                        PG0[g] = partner32(g0, hi); PG1[g] = partner32(g1, hi); T0[g] = g0 + PG0[g]; T1[g] = g1 + PG1[g];
                    }
                    const float tot1 = (T1[0] + T1[1]) + (T1[2] + T1[3]), tot0 = (T0[0] + T0[1]) + (T0[2] + T0[3]);
                    float ST1[4], ST0[4];
                    ST1[3] = 0.f; ST1[2] = T1[3]; ST1[1] = ST1[2] + T1[2]; ST1[0] = ST1[1] + T1[1];
                    ST0[3] = tot1; ST0[2] = ST0[3] + T0[3]; ST0[1] = ST0[2] + T0[2]; ST0[0] = ST0[1] + T0[1];
#pragma unroll
                    for (int g = 0; g < 4; ++g) {
                        const float b0 = carry + ST0[g] + (hi == 0 ? PG0[g] : 0.f), b1 = carry + ST1[g] + (hi == 0 ? PG1[g] : 0.f);
                        L0[4 * g + 3] += b0; L0[4 * g + 2] += L0[4 * g + 3]; L0[4 * g + 1] += L0[4 * g + 2]; L0[4 * g] += L0[4 * g + 1];
                        L1[4 * g + 3] += b1; L1[4 * g + 2] += L1[4 * g + 3]; L1[4 * g + 1] += L1[4 * g + 2]; L1[4 * g] += L1[4 * g + 1];
                    }
#pragma unroll
                    for (int r = 0; r < 16; ++r) { p0[r] = __builtin_amdgcn_exp2f(p0[r] + L0[r]); p1[r] = __builtin_amdgcn_exp2f(p1[r] + L1[r]); }
                    carry += tot0 + tot1;
                    wdone = !__any(!(carry < -150.f));
                } else {
                    f32x16 negm;
                    { const float nm = NOMAX ? cq : cq - mhat;
#pragma unroll
                      for (int r = 0; r < 16; ++r) negm[r] = nm; }
                    asm volatile("" : "+v"(negm));
                    qkt(p0, p1, kb, qr, negm);
                    if (MODE == 1) {
#pragma unroll
                        for (int g = 0; g < 4; ++g) {
                            const f32x4 c0 = *(const LAS f32x4*)(cum + kt * 64 + 8 * g + 4 * hi), c1 = *(const LAS f32x4*)(cum + kt * 64 + 32 + 8 * g + 4 * hi);
#pragma unroll
                            for (int i = 0; i < 4; ++i) { p0[4 * g + i] -= c0[i]; p1[4 * g + i] -= c1[i]; }
                        }
                        if (diag) {
#pragma unroll
                            for (int r = 0; r < 16; ++r) { const int kv = crow(r, hi); if (kv > trel) p0[r] = -INFINITY; if (kv + 32 > trel) p1[r] = -INFINITY; }
                        }
                    }
                    const float rm = NOMAX ? 0.f : rowmax(p0, p1);
                    if (NOMAX) {
                    } else if (it == it0) {
                        mhat = rm;
#pragma unroll
                        for (int r = 0; r < 16; ++r) { p0[r] -= rm; p1[r] -= rm; }
                    } else if (__any(rm > 8.0f)) {
                        const float dl = fmaxf(rm, 0.f); mhat += dl;
#pragma unroll
                        for (int r = 0; r < 16; ++r) { p0[r] -= dl; p1[r] -= dl; }
                        const float f = __builtin_amdgcn_exp2f(-dl); l_reg *= f;
                        if (hi == 0) wsf[r32] = f;
                        asm volatile("s_waitcnt lgkmcnt(0)" ::: "memory");
#pragma unroll
                        for (int g = 0; g < 4; ++g) { const f32x4 fv = *(const LAS f32x4*)(wsf + 8 * g + 4 * hi);
#pragma unroll
                            for (int d = 0; d < ND; ++d)
#pragma unroll
                                for (int i = 0; i < 4; ++i) o[d][4 * g + i] *= fv[i]; }
                    }
                    float sacc = 0.f;
#pragma unroll
                    for (int r = 0; r < 16; ++r) { p0[r] = __builtin_amdgcn_exp2f(p0[r]); p1[r] = __builtin_amdgcn_exp2f(p1[r]); sacc += p0[r] + p1[r]; }
                    l_reg += sacc;
                }
                pw0 = (u32x4){cvtpk(p0[0], p0[1]), cvtpk(p0[2], p0[3]), cvtpk(p0[4], p0[5]), cvtpk(p0[6], p0[7])};
                pw1 = (u32x4){cvtpk(p0[8], p0[9]), cvtpk(p0[10], p0[11]), cvtpk(p0[12], p0[13]), cvtpk(p0[14], p0[15])};
                pw2 = (u32x4){cvtpk(p1[0], p1[1]), cvtpk(p1[2], p1[3]), cvtpk(p1[4], p1[5]), cvtpk(p1[6], p1[7])};
                pw3 = (u32x4){cvtpk(p1[8], p1[9]), cvtpk(p1[10], p1[11]), cvtpk(p1[12], p1[13]), cvtpk(p1[14], p1[15])};
                if (!lag) ATT_PV(vbl + vs * 16384); else pend = true;
            }
            vsp = vs; vs = vsn;
            if (MODE == 0) { if (__syncthreads_and(wdone ? 1 : 0)) break; }
        }
        if (lag && pend) ATT_PV(vbl + vsp * 16384);
#undef ATT_PV
        if (MODE != 0) {
            const float lt = l_reg + partner32(l_reg, hi);
            if (hi == 0) wsf[32 + r32] = lt;
            asm volatile("s_waitcnt lgkmcnt(0)" ::: "memory");
#pragma unroll
            for (int g = 0; g < 4; ++g) { const f32x4 lv = *(const LAS f32x4*)(wsf + 32 + 8 * g + 4 * hi);
#pragma unroll
                for (int i = 0; i < 4; ++i) { const float rl = __builtin_amdgcn_rcpf(lv[i]);
#pragma unroll
                    for (int d = 0; d < ND; ++d) o[d][4 * g + i] *= rl; } }
        }
        if (MODE == 2 && pass == 0) {
#pragma unroll
            for (int r = 0; r < 16; ++r) { const int orow = crow(r, hi);
#pragma unroll
                for (int d = 0; d < ND; ++d) stg[orow * DV + d * 32 + r32] = (bf16_t)(cvtpk(o[d][r], 0.f) & 0xffffu); }
        }
        if (MODE == 2 && pass == 1) {
            float ssr[16];
#pragma unroll
            for (int r = 0; r < 16; ++r) ssr[r] = 0.f;
#pragma unroll
            for (int r = 0; r < 16; ++r) { const int orow = crow(r, hi);
#pragma unroll
                for (int d = 0; d < ND; ++d) { const float a0 = __uint_as_float((unsigned)stg[orow * DV + d * 32 + r32] << 16);
                    o[d][r] = a0 - lam * o[d][r]; ssr[r] += o[d][r] * o[d][r]; } }
#pragma unroll
            for (int r = 0; r < 16; ++r) {
#pragma unroll
                for (int x = 1; x < 32; x <<= 1) ssr[r] += __shfl_xor(ssr[r], x);
                ssr[r] = __builtin_amdgcn_rsqf(ssr[r] * (1.0f / 128.0f) + EPS) * oscale;
            }
#pragma unroll
            for (int d = 0; d < ND; ++d) { const float gsl = subln[d * 32 + r32];
#pragma unroll
                for (int r = 0; r < 16; ++r) o[d][r] *= ssr[r] * gsl; }
        }
        if (MODE != 2 || pass == 1) {
#pragma unroll
            for (int r = 0; r < 16; ++r) { const int orow = crow(r, hi);
#pragma unroll
                for (int d = 0; d < ND; ++d) stg[orow * DV + d * 32 + r32] = (bf16_t)(cvtpk(o[d][r], 0.f) & 0xffffu); }
            asm volatile("s_waitcnt lgkmcnt(0)" ::: "memory");
            if (DV == 64) {
#pragma unroll
                for (int i = 0; i < 4; ++i) { const int row = i * 8 + (lane >> 3), ch = lane & 7; const u32x4 v = *(const LAS u32x4*)(stg + row * 64 + ch * 8); *(GAS u32x4*)(Ow + (size_t)row * AOP + ch * 8) = v; }
            } else {
#pragma unroll
                for (int i = 0; i < 8; ++i) { const int row = i * 4 + (lane >> 4), ch = lane & 15; const u32x4 v = *(const LAS u32x4*)(stg + row * 128 + ch * 8); *(GAS u32x4*)(Ow + (size_t)row * AOP + ch * 8) = v; }
            }
        }
        __syncthreads();
    }
}
}

__device__ __forceinline__ float wave_sum(float v) {
#pragma unroll
    for (int o = 1; o < 64; o <<= 1) v += __shfl_xor(v, o);
    return v;
}
struct MatDesc { const float* src; const float* gain; bf16_t* dst; int ldw, K, Np, kind; };
__device__ __forceinline__ void xpose_item(const MatDesc& d, int item, LAS float* scr, int lane) {
    const int nblk = d.Np / 32, kb = item / nblk, nb = item % nblk, k0 = 64 * kb, n0 = 32 * nb;
    int sc = n0, nvalid = 32;
    if (d.kind == 1) { const int tile = n0 >> 8, w = n0 & 255; sc = (w < 128) ? 128 * tile + w : DFF + 128 * tile + (w - 128); }
    else if (d.kind == 2) { const int T = n0 >> 8, w = n0 & 255;
        if (T == 12) { sc = 1536; nvalid = (w == 0) ? 4 : 0; }
        else { const int hh = (w >> 5) & 3, dd = 32 * (w >> 7), L = 256 * T + 64 * hh + dd; sc = (L < 1536) ? L : L + 4; } }
    {
        const int r8 = lane >> 3, q = lane & 7; const bool ok = (4 * q < nvalid);
        f32x4 v[8];
#pragma unroll
        for (int i = 0; i < 8; ++i) v[i] = ok ? *(const f32x4*)(d.src + (size_t)(k0 + 8 * i + r8) * d.ldw + sc + 4 * q) : (f32x4){0.f, 0.f, 0.f, 0.f};
#pragma unroll
        for (int i = 0; i < 8; ++i) { const int kk = 8 * i + r8; const float gm = d.gain ? d.gain[k0 + kk] : 1.f;
            LAS float* sp = scr + kk * 33 + 4 * q; sp[0] = v[i][0] * gm; sp[1] = v[i][1] * gm; sp[2] = v[i][2] * gm; sp[3] = v[i][3] * gm; }
    }
    asm volatile("s_waitcnt lgkmcnt(0)" ::: "memory");
    const int c = lane & 7;
#pragma unroll
    for (int jj = 0; jj < 4; ++jj) { const int n = (lane >> 3) + 8 * jj; const LAS float* s = scr + (8 * c) * 33 + n;
        u32x4 o; o.x = cvtpk(s[0 * 33], s[1 * 33]); o.y = cvtpk(s[2 * 33], s[3 * 33]); o.z = cvtpk(s[4 * 33], s[5 * 33]); o.w = cvtpk(s[6 * 33], s[7 * 33]);
        *(u32x4*)(d.dst + (size_t)(n0 + n) * d.K + k0 + 8 * c) = o; }
    asm volatile("s_waitcnt lgkmcnt(0)" ::: "memory");
}

#define XB_TMO      128
#define XB_XCNT(j)  (256  + 64 * (j))
#define XB_XSUB(j)  (1280 + 64 * (j))
#define XB_XGEN(j)  (2304 + 64 * (j))
#define XB_TOP      3328
#define XB_TOPGEN   3392
#define XCD_BAR_WORDS 3456
#define XB_SPIN_CAP (1u << 18)
__device__ __forceinline__ unsigned xb_ld(unsigned* p)              { return __hip_atomic_load(p, __ATOMIC_RELAXED, __HIP_MEMORY_SCOPE_AGENT); }
__device__ __forceinline__ unsigned xb_add(unsigned* p, unsigned v) { return __hip_atomic_fetch_add(p, v, __ATOMIC_RELAXED, __HIP_MEMORY_SCOPE_AGENT); }
__device__ __forceinline__ unsigned xb_xcc_id() { return (unsigned)__builtin_amdgcn_s_getreg((3 << 11) | 20) & 0xFu; }
#define XB_SPIN(cond, bar) do { unsigned _sp = 0; while (cond) { __builtin_amdgcn_s_sleep(1); \
    if ((++_sp & 255u) == 0u) { if (xb_ld(&(bar)[XB_TMO])) break; if (_sp > XB_SPIN_CAP) { atomicAdd(&(bar)[XB_TMO], 1u); break; } } } } while (0)
struct XcdBarrier { unsigned* bar; unsigned x; volatile LAS unsigned* st; };
__device__ __forceinline__ XcdBarrier xcd_barrier_post(unsigned* bar, volatile LAS unsigned* st) {
    XcdBarrier b; b.bar = bar; b.x = xb_xcc_id(); b.st = st;
    if (threadIdx.x == 0) (void)xb_add(&bar[XB_XCNT(b.x)], 1u);
    return b;
}
__device__ __forceinline__ void xcd_barrier_complete(unsigned* bar, unsigned x, unsigned& nloc, unsigned& nx) {
    const unsigned G = gridDim.x * gridDim.y * gridDim.z;
    unsigned sum, cnt, mine, sp = 0u;
    for (;;) {
        sum = 0u; cnt = 0u; mine = 0u;
#pragma unroll
        for (unsigned j = 0; j < 16; ++j) { const unsigned c = xb_ld(&bar[XB_XCNT(j)]); sum += c; cnt += (c > 0u) ? 1u : 0u; mine = (j == x) ? c : mine; }
        if (sum == G) break;
        __builtin_amdgcn_s_sleep(1);
        if ((++sp & 255u) == 0u) { if (xb_ld(&bar[XB_TMO])) break; if (sp > XB_SPIN_CAP) { atomicAdd(&bar[XB_TMO], 1u); break; } }
    }
    nloc = mine > 0u ? mine : 1u; nx = cnt > 0u ? cnt : 1u;
}
__device__ __forceinline__ void xcd_barrier(unsigned* bar, unsigned x, volatile LAS unsigned* st) {
    asm volatile("s_waitcnt vmcnt(0)" ::: "memory");
    __syncthreads();
    if (threadIdx.x == 0) {
        __builtin_amdgcn_s_waitcnt(0);
        unsigned nloc = st[0], nx = st[1];
        if (nloc == 0u) { xcd_barrier_complete(bar, x, nloc, nx); st[0] = nloc; st[1] = nx; }
        const unsigned old = xb_add(&bar[XB_XSUB(x)], 1u);
        const unsigned gen = old / nloc;
        if (old + 1u == (gen + 1u) * nloc) {
            __builtin_amdgcn_fence(__ATOMIC_RELEASE, "agent");
            asm volatile("s_waitcnt vmcnt(0)" ::: "memory");
            const unsigned og = xb_add(&bar[XB_TOP], 1u);
            const unsigned tg = og / nx;
            if (og + 1u == (tg + 1u) * nx) xb_add(&bar[XB_TOPGEN], 1u);
            else XB_SPIN(xb_ld(&bar[XB_TOPGEN]) == tg, bar);
            __builtin_amdgcn_fence(__ATOMIC_ACQUIRE, "agent");
            xb_add(&bar[XB_XGEN(x)], 1u);
            asm volatile("s_waitcnt vmcnt(0)" ::: "memory");
        } else {
            XB_SPIN(xb_ld(&bar[XB_XGEN(x)]) == gen, bar);
            __builtin_amdgcn_fence(__ATOMIC_ACQUIRE, "agent");
            asm volatile("s_waitcnt vmcnt(0)" ::: "memory");
        }
    }
    __syncthreads();
}
constexpr size_t WS_BAR = 65536;

struct Args { const void* in[21]; float* out; unsigned char* ws; };
struct Desc { const bf16_t* A; const bf16_t* Bt; const float* ssq_in; float* ssq_out; bf16_t* o16; const float* gfox; const float* gdiff; const float* bfg; const float* subln; const float* pl; const bf16_t* hin;
              int lda, ldb, N, K, mode, flag, sync, fin; float scale, lam, oscale, padf; };
template <class T> __device__ __forceinline__ T* uni_ptr(T* p) { const unsigned long long v = (unsigned long long)(uintptr_t)p;
    const unsigned lo = __builtin_amdgcn_readfirstlane((unsigned)v), hi = __builtin_amdgcn_readfirstlane((unsigned)(v >> 32));
    return (T*)(__attribute__((address_space(1))) T*)(uintptr_t)(((unsigned long long)hi << 32) | lo); }
__device__ __forceinline__ int uni_i(int v) { return __builtin_amdgcn_readfirstlane(v); }
__device__ __forceinline__ float uni_f(float v) { return __uint_as_float(__builtin_amdgcn_readfirstlane(__float_as_uint(v))); }
constexpr int EM_ATTN = 7, NSTEP = 15;
constexpr size_t WS_TAB = 4096;

__global__ void __launch_bounds__(512) fwd_megakernel(Args a) {
    extern __shared__ __attribute__((aligned(16))) unsigned char lds_raw[];
    LAS unsigned char* lds = (LAS unsigned char*)lds_raw;
    cg::grid_group grid = cg::this_grid();
    const int tid = threadIdx.x;

    {
        const int lane = tid & 63, wave = __builtin_amdgcn_readfirstlane(tid >> 6);
        const int G = gridDim.x, bx = blockIdx.x;
        unsigned char* ws = a.ws;
        const float* x = (const float*)a.in[0]; const float* pin = (const float*)a.in[1]; const int* positions = (const int*)a.in[2];
        const float* ffn1_norm = (const float*)a.in[3]; const float* ffn1_wi = (const float*)a.in[4]; const float* ffn1_wo = (const float*)a.in[5];
        const float* mix_norm = (const float*)a.in[6]; const float* w_in = (const float*)a.in[7]; const float* b_forget = (const float*)a.in[8];
        const float* qk_gain_fox = (const float*)a.in[9]; const float* qk_gain_diff = (const float*)a.in[10]; const float* diff_lambda = (const float*)a.in[11];
        const float* diff_subln = (const float*)a.in[12]; const float* w_br = (const float*)a.in[13]; const float* w_o = (const float*)a.in[14];
        const float* ffn2_norm = (const float*)a.in[15]; const float* ffn2_wi = (const float*)a.in[16]; const float* ffn2_wo = (const float*)a.in[17];
        const float* ple_norm = (const float*)a.in[18]; const float* ple_gate_w = (const float*)a.in[19]; const float* ple_proj_w = (const float*)a.in[20];
        float* out = a.out;
        unsigned* ctl = (unsigned*)(ws + WS_CTL);
        float* SS = (float*)(ws + WS_SS);
        float* cosT = (float*)(ws + WS_COS); float* sinT = (float*)(ws + WS_SIN);
        bf16_t* Wb = (bf16_t*)(ws + WS_W);
        bf16_t* HB = (bf16_t*)(ws + WS_HB); bf16_t* BIG = (bf16_t*)(ws + WS_BIG); bf16_t* GS = (bf16_t*)(ws + WS_GS); bf16_t* AO = (bf16_t*)(ws + WS_AO); bf16_t* PB = (bf16_t*)(ws + WS_PB);
        bf16_t* M16 = (bf16_t*)(ws + WS_BIG + 128 * MiB);
        const int gw = bx * 8 + wave, NGW = G * 8; const int gt = bx * 512 + tid, NGT = G * 512;
        if (gt < 16) ctl[gt] = 0u;
        if (gt < XCD_BAR_WORDS) ((unsigned*)(ws + WS_BAR))[gt] = 0u;
        if (tid < 2) ((volatile LAS unsigned*)(lds + att::LMISC + 128))[tid] = 0u;
        if (bx == 0 && wave >= 4) {
            const int l = wave - 4; const float* lf = diff_lambda + l * 256;
            const float s1 = wave_sum(lf[lane] * lf[64 + lane]), s2 = wave_sum(lf[128 + lane] * lf[192 + lane]);
            const float lam_init = 0.8f - 0.6f * expf(-0.3f * (float)l);
            if (lane == 0) ((float*)ctl)[16 + l] = expf(s1) - expf(s2) + lam_init;
        }
        if (bx == 0 && tid < NLAYER * NSTEP) {
            Desc* tab = (Desc*)(ws + WS_TAB);
            const int l = tid / NSTEP, st = tid % NSTEP;
            {
                const float lam_init = 0.8f - 0.6f * expf(-0.3f * (float)l);
                bf16_t* WL = Wb + (size_t)l * LAYER_W_ELEMS; float* SSl = SS + (size_t)(4 * l) * MTOK;
                {
                    Desc* d = tab + l * NSTEP + st;
                    const bf16_t* A = HB; const bf16_t* Bt = WL; const float* ssq_in = SSl; float* ssq_out = SSl; bf16_t* o16 = GS;
                    int lda = DM, ldb = DM, N = DM, K = DM, mode = 0, flag = 0, sync = 1; float scale = 1.f;
                    switch (st) {
                        case 0: A = AO; Bt = WL + OW_1I; N = 2 * DFF; mode = pg8::EM_SWIGLU; ssq_in = SSl; o16 = BIG; break;
                        case 1: A = BIG; lda = DFF; Bt = WL + OW_1O; ldb = DFF; K = DFF; mode = pg8::EM_RES; scale = 0.5f; o16 = HB; ssq_out = SSl + MTOK; break;
                        case 2: A = HB; Bt = WL + OW_IN; N = NIN; mode = pg8::EM_QKV; ssq_in = SSl + MTOK; o16 = BIG; break;
                        case 3: mode = EM_ATTN; break;
                        case 4: case 6: case 8: A = HB; Bt = WL + OW_G + (size_t)((st - 4) >> 1) * DM * DM; mode = pg8::EM_GATE; ssq_in = SSl + MTOK; o16 = GS; sync = 0; break;
                        case 5: A = AO; Bt = WL + OW_BR; K = 256; ldb = 256; mode = pg8::EM_MERGE; flag = 0; o16 = M16; sync = 0; break;
                        case 7: A = AO + 256; Bt = WL + OW_BR + 262144; K = 256; ldb = 256; mode = pg8::EM_MERGE; flag = 1; o16 = M16; sync = 0; break;
                        case 9: A = AO + 512; Bt = WL + OW_BR + 524288; K = 512; ldb = 512; mode = pg8::EM_MERGE; flag = 2; o16 = M16; break;
                        case 10: A = M16; Bt = WL + OW_O; mode = pg8::EM_RES; scale = 1.0f; o16 = HB; ssq_out = SSl + 2 * MTOK; break;
                        case 11: A = HB; Bt = WL + OW_2I; N = 2 * DFF; mode = pg8::EM_SWIGLU; ssq_in = SSl + 2 * MTOK; o16 = BIG; break;
                        case 12: A = BIG; lda = DFF; Bt = WL + OW_2O; ldb = DFF; K = DFF; mode = pg8::EM_RES; scale = 0.5f; o16 = HB; ssq_out = SSl + 3 * MTOK; break;
                        case 13: A = PB; lda = PDIM; Bt = WL + OW_PP; ldb = PDIM; K = PDIM; mode = pg8::EM_STORE; o16 = GS; sync = 0; break;
                        default: A = HB; Bt = WL + OW_PG; mode = pg8::EM_PLE; ssq_in = SSl + 3 * MTOK; ssq_out = SSl + 4 * MTOK; o16 = AO; break;
                    }
                    d->A = A; d->Bt = Bt; d->ssq_in = ssq_in; d->ssq_out = ssq_out; d->o16 = o16;
                    d->gfox = qk_gain_fox + l * 128; d->gdiff = qk_gain_diff + l * 128; d->bfg = b_forget + l * 4; d->subln = diff_subln + l * 128; d->pl = pin + (size_t)l * MTOK * PDIM;
                    d->lda = lda; d->ldb = ldb; d->N = N; d->K = K; d->mode = mode; d->flag = flag; d->sync = sync; d->fin = (l == NLAYER - 1 && st == NSTEP - 1) ? 1 : 0;
                    d->hin = (st == 1) ? AO : HB;
                    d->scale = scale; d->lam = 0.f; d->oscale = 1.0f - lam_init; d->padf = 0.f;
                }
            }
        }
        for (int i = gt; i < 16 * MTOK; i += NGT) SS[MTOK + i] = 0.f;
        for (int i = gt; i < MTOK * 8; i += NGT) {
            const int m = i >> 3, f = i & 7; const float inv = powf(500000.0f, -(float)f * 0.125f);
            const float ang = (float)positions[m] * inv; cosT[i] = cosf(ang); sinT[i] = sinf(ang);
        }
        LAS float* scr = (LAS float*)(lds + wave * 16384);
        {
            constexpr int IT_WI = 16 * 176, IT_WO = 44 * 32, IT_IN = 16 * 104, IT_SQ = 16 * 32, IT_B4 = 4 * 32, IT_B8 = 8 * 32, IT_PP = 4 * 32;
            constexpr int IT_LAYER = 2 * IT_WI + 2 * IT_WO + IT_IN + 5 * IT_SQ + 2 * IT_B4 + IT_B8 + IT_PP;
#pragma unroll 1
            for (int gi = gw; gi < NLAYER * IT_LAYER; gi += NGW) {
                const int l = gi / IT_LAYER; int r = gi - l * IT_LAYER;
                bf16_t* WL = Wb + (size_t)l * LAYER_W_ELEMS;
                MatDesc d; d.gain = nullptr; d.ldw = DM; d.K = DM; d.Np = DM; d.kind = 0;
                if (r < IT_WI) { d.src = ffn1_wi + (size_t)l * DM * 2 * DFF; d.ldw = 2 * DFF; d.Np = 2 * DFF; d.kind = 1; d.gain = ffn1_norm + l * DM; d.dst = WL + OW_1I; }
                else if ((r -= IT_WI) < IT_WI) { d.src = ffn2_wi + (size_t)l * DM * 2 * DFF; d.ldw = 2 * DFF; d.Np = 2 * DFF; d.kind = 1; d.gain = ffn2_norm + l * DM; d.dst = WL + OW_2I; }
                else if ((r -= IT_WI) < IT_WO) { d.src = ffn1_wo + (size_t)l * DFF * DM; d.K = DFF; d.dst = WL + OW_1O; }
                else if ((r -= IT_WO) < IT_WO) { d.src = ffn2_wo + (size_t)l * DFF * DM; d.K = DFF; d.dst = WL + OW_2O; }
                else if ((r -= IT_WO) < IT_IN) { d.src = w_in + (size_t)l * DM * INCOLS; d.ldw = INCOLS; d.Np = NIN; d.kind = 2; d.gain = mix_norm + l * DM; d.dst = WL + OW_IN; }
                else if ((r -= IT_IN) < 3 * IT_SQ) { const int gidx = r / IT_SQ; r -= gidx * IT_SQ; d.src = w_in + (size_t)l * DM * INCOLS + 3076 + 1024 * gidx; d.ldw = INCOLS; d.gain = mix_norm + l * DM; d.dst = WL + OW_G + (size_t)gidx * DM * DM; }
                else if ((r -= 3 * IT_SQ) < IT_SQ) { d.src = w_o + (size_t)l * DM * DM; d.dst = WL + OW_O; }
                else if ((r -= IT_SQ) < IT_SQ) { d.src = ple_gate_w + (size_t)l * DM * DM; d.gain = ple_norm + l * DM; d.dst = WL + OW_PG; }
                else if ((r -= IT_SQ) < IT_B4) { d.src = w_br + (size_t)l * DM * DM; d.K = 256; d.dst = WL + OW_BR; }
                else if ((r -= IT_B4) < IT_B4) { d.src = w_br + (size_t)l * DM * DM + 256 * DM; d.K = 256; d.dst = WL + OW_BR + 262144; }
                else if ((r -= IT_B4) < IT_B8) { d.src = w_br + (size_t)l * DM * DM + 512 * DM; d.K = 512; d.dst = WL + OW_BR + 524288; }
                else { r -= IT_B8; d.src = ple_proj_w + (size_t)l * PDIM * DM; d.K = PDIM; d.dst = WL + OW_PP; }
                xpose_item(d, r, scr, lane);
            }
        }
        for (int m = gw; m < MTOK; m += NGW) {
            const f32x4* xr = (const f32x4*)(x + (size_t)m * DM) + lane;
            u32x2* hb = (u32x2*)(AO + (size_t)m * DM) + lane; u32x2* lb = (u32x2*)((bf16_t*)(ws + WS_LO) + (size_t)m * DM) + lane;
            float s2 = 0.f;
#pragma unroll
            for (int j = 0; j < 4; ++j) { const f32x4 v = xr[64 * j]; s2 += dot4(v); u32x2 w; w.x = cvtpk(v[0], v[1]); w.y = cvtpk(v[2], v[3]); hb[64 * j] = w;
                f32x4 g; g[0] = __uint_as_float(w.x << 16); g[1] = __uint_as_float(w.x & 0xffff0000u); g[2] = __uint_as_float(w.y << 16); g[3] = __uint_as_float(w.y & 0xffff0000u);
                u32x2 wl; wl.x = cvtpk(v[0] - g[0], v[1] - g[1]); wl.y = cvtpk(v[2] - g[2], v[3] - g[3]); lb[64 * j] = wl; }
            s2 = wave_sum(s2);
            if (lane == 0) SS[m] = s2;
        }
    }
    grid.sync();
    const unsigned xcc = xcd_barrier_post((unsigned*)(a.ws + WS_BAR), (volatile LAS unsigned*)(lds + att::LMISC + 128)).x;
#define GRID_BAR() xcd_barrier((unsigned*)(ws + WS_BAR), xcc, (volatile LAS unsigned*)(lds + att::LMISC + 128))

#pragma unroll 1
    for (int ls = 0; ls < NLAYER * NSTEP; ++ls) {
        unsigned char* ws = a.ws; asm volatile("" : "+s"(ws) :: "memory"); ws = (unsigned char*)(__attribute__((address_space(1))) unsigned char*)ws;
        float* out = a.out; asm volatile("" : "+s"(out)); out = (float*)(__attribute__((address_space(1))) float*)out;
        const Desc* dp = (const Desc*)(ws + WS_TAB) + ls;
        const int mode = uni_i(dp->mode);
        const int G = gridDim.x, bx = blockIdx.x;
        if (mode == EM_ATTN) {
            unsigned* ctl = (unsigned*)(ws + WS_CTL) + ls / NSTEP;
            const GAS bf16_t* QKVb = (const GAS bf16_t*)(ws + WS_BIG); GAS bf16_t* AOb = (GAS bf16_t*)(ws + WS_AO); const GAS float* logfB = (const GAS float*)(ws + WS_LOGF);
            const float lam = uni_f(((const float*)(ws + WS_CTL))[16 + ls / NSTEP]), oscale = uni_f(dp->oscale); const GAS float* subln = (const GAS float*)uni_ptr(dp->subln); const GAS float* gfoxp = (const GAS float*)uni_ptr(dp->gfox);
            LAS int* qslot = (LAS int*)(lds + att::LMISC);
            bool nomaxB, nomaxC;
            {
                const GAS float* gd = (const GAS float*)uni_ptr(dp->gdiff); const int ln = tid & 63;
                float a = fabsf(gfoxp[ln]), bq = fabsf(gfoxp[64 + ln]), c = fabsf(gd[ln]), d = fabsf(gd[64 + ln]);
#pragma unroll
                for (int o = 1; o < 64; o <<= 1) { a = fmaxf(a, __shfl_xor(a, o)); bq = fmaxf(bq, __shfl_xor(bq, o)); c = fmaxf(c, __shfl_xor(c, o)); d = fmaxf(d, __shfl_xor(d, o)); }
                nomaxB = __builtin_amdgcn_readfirstlane((64.0f * C2 * a * bq * 1.03f + 1.0f) <= 40.0f ? 1 : 0) != 0;
                nomaxC = __builtin_amdgcn_readfirstlane((64.0f * C2 * c * d * 1.03f + 1.0f) <= 40.0f ? 1 : 0) != 0;
            }
#ifndef ATT_REPS
#define ATT_REPS 1
#endif
            for (int rep = 0; rep < ATT_REPS; ++rep)
            for (;;) {
                if (tid == 0) qslot[0] = (int)atomicAdd(ctl + 4 * rep, 1u);
                __syncthreads();
                const int idx = qslot[0];
                __syncthreads();
                if (idx >= 1536) break;
                const int kind = idx >> 9, r = idx & 511, qb = 15 - (r >> 5), bh = r & 31, b = bh >> 2, hh = bh & 3;
                if (kind == 0) { if (nomaxC) att::attn_unit<2, true>(b, hh, qb, QKVb, AOb, logfB, subln, lam, oscale, lds); else att::attn_unit<2, false>(b, hh, qb, QKVb, AOb, logfB, subln, lam, oscale, lds); }
                else if (kind == 1) { if (nomaxB) att::attn_unit<1, true>(b, hh, qb, QKVb, AOb, logfB, gfoxp, 0.f, 1.f, lds); else att::attn_unit<1, false>(b, hh, qb, QKVb, AOb, logfB, gfoxp, 0.f, 1.f, lds); }
                else att::attn_unit<0>(b, hh, qb, QKVb, AOb, logfB, nullptr, 0.f, 1.f, lds);
            }
            GRID_BAR();
            continue;
        }
        if (ls % NSTEP == 11) {
            const float* pl = uni_ptr(dp->pl); bf16_t* PB = (bf16_t*)(ws + WS_PB);
            for (size_t i = (size_t)bx * 512 + tid; i < (size_t)MTOK * PDIM / 8; i += (size_t)G * 512) {
                const f32x4 v0 = *(const f32x4*)(pl + i * 8), v1 = *(const f32x4*)(pl + i * 8 + 4); *(u32x4*)(PB + i * 8) = pack8(v0, v1); }
        }
        pg8::Gemm g; pg8::Epi e;
        g.A = uni_ptr(dp->A); g.Bt = uni_ptr(dp->Bt); g.lda = uni_i(dp->lda); g.ldb = uni_i(dp->ldb); g.M = MTOK; g.N = uni_i(dp->N); g.K = uni_i(dp->K);
        e.mode = mode; e.flag = uni_i(dp->flag); e.scale = uni_f(dp->scale); e.ssq_in = (const GAS float*)uni_ptr(dp->ssq_in); e.ssq_out = (GAS float*)uni_ptr(dp->ssq_out); e.h = (GAS float*)out; e.o16 = (GAS bf16_t*)uni_ptr(dp->o16);
        e.mf = (GAS float*)(ws + WS_BIG); e.g16 = (const GAS bf16_t*)(ws + WS_GS);
        e.hin = (const GAS bf16_t*)uni_ptr(dp->hin); e.lo = (GAS bf16_t*)(ws + WS_LO); e.fin = uni_i(dp->fin);
        e.gfox = (const GAS float*)uni_ptr(dp->gfox); e.gdiff = (const GAS float*)uni_ptr(dp->gdiff); e.cosT = (const GAS float*)(ws + WS_COS); e.sinT = (const GAS float*)(ws + WS_SIN); e.bfg = (const GAS float*)uni_ptr(dp->bfg); e.logf = (GAS float*)(ws + WS_LOGF);
        const int do_sync = uni_i(dp->sync);
        pg8::StaticOrder S; S.init(g.M, g.N, G, bx);
        pg8::gemm_phase(lds, g, S, e);
#ifdef REP_MASK
        if ((REP_MASK >> (ls % NSTEP)) & 1) pg8::gemm_phase(lds, g, S, e);
#endif
        if (do_sync) GRID_BAR();
#ifdef SYNC_REPS
        if (do_sync) GRID_BAR();
#endif
    }
}

extern "C" void kernel_launch(void* const* d_in, const int* in_sizes, int n_in, void* d_out, int out_size, void* d_ws, size_t ws_size, hipStream_t stream) {
    static int grid = 0;
    if (grid == 0) {
        if (n_in != 21 || out_size != MTOK * DM || ws_size < WS_END) { fprintf(stderr, "kernel_launch: unexpected shapes: n_in %d out %d ws %zu (need %zu)\n", n_in, out_size, ws_size, (size_t)WS_END); grid = -1; return; }
        int dev = 0, cus = 0, per_cu = 0;
        hipGetDevice(&dev);
        hipDeviceGetAttribute(&cus, hipDeviceAttributeMultiprocessorCount, dev);
        hipFuncSetAttribute((const void*)fwd_megakernel, hipFuncAttributeMaxDynamicSharedMemorySize, LDS_BYTES);
        hipOccupancyMaxActiveBlocksPerMultiprocessor(&per_cu, (const void*)fwd_megakernel, 512, LDS_BYTES);
        if (per_cu < 1) { fprintf(stderr, "kernel_launch: occupancy query says %d blocks per CU\n", per_cu); per_cu = 1; }
        (void)hipGetLastError();
        grid = cus * per_cu;
    }
    if (grid < 0) return;
    Args a{};
    for (int i = 0; i < 21; ++i) a.in[i] = d_in[i];
    a.out = (float*)d_out; a.ws = (unsigned char*)d_ws;
    void* args[] = {&a};
    hipError_t e = hipLaunchCooperativeKernel((const void*)fwd_megakernel, dim3(grid), dim3(512), args, LDS_BYTES, stream);
    if (e != hipSuccess) fprintf(stderr, "cooperative launch failed: %s (grid %d)\n", hipGetErrorString(e), grid);
}
```

```cpp
#include <hip/hip_runtime.h>
#include <hip/hip_cooperative_groups.h>
#include <cstdio>
#include <cstdint>
namespace cg = cooperative_groups;

#define LAS __attribute__((address_space(3)))
#define GAS __attribute__((address_space(1)))
typedef unsigned short bf16_t;
typedef short bf16x8 __attribute__((ext_vector_type(8)));
typedef short s16x4 __attribute__((ext_vector_type(4)));
typedef float f32x4 __attribute__((ext_vector_type(4)));
typedef float f32x16 __attribute__((ext_vector_type(16)));
typedef unsigned u32x4 __attribute__((ext_vector_type(4)));
typedef unsigned u32x2 __attribute__((ext_vector_type(2)));
typedef float f32x2_t __attribute__((ext_vector_type(2)));
typedef __bf16 bf16x2_t __attribute__((ext_vector_type(2)));

constexpr int MTOK = 32768, DM = 1024, SEQ = 4096, NBATCH = 8, DFF = 2816, NLAYER = 4, PDIM = 256;
constexpr int INCOLS = 6148, NQKV = 3072, NIN = 3328;
constexpr float EPS = 1e-6f, L2E = 1.4426950408889634f, C2 = 0.125f * 1.4426950408889634f;

constexpr size_t MiB = 1u << 20;
constexpr size_t WS_CTL = 0;
constexpr size_t WS_SS = 1 * MiB;
constexpr size_t WS_COS = 4 * MiB, WS_SIN = 5 * MiB, WS_LOGF = 6 * MiB;
constexpr size_t WS_W = 8 * MiB;
constexpr size_t LAYER_W_ELEMS = 27262976;
constexpr size_t OW_1I = 0, OW_1O = 5767168, OW_IN = 8650752, OW_G = 12058624, OW_BR = 15204352, OW_O = 16252928, OW_2I = 17301504, OW_2O = 23068672, OW_PG = 25952256, OW_PP = 27000832;
constexpr size_t WS_HB = 216 * MiB;
constexpr size_t WS_BIG = 280 * MiB;
constexpr size_t WS_GS = 472 * MiB;
constexpr size_t WS_AO = 536 * MiB;
constexpr size_t WS_LO = 600 * MiB;
constexpr size_t WS_END = 664 * MiB;
constexpr size_t WS_PB = WS_BIG + 176 * MiB;

constexpr int LDS_BYTES = 147456;

__device__ __forceinline__ unsigned cvtpk(float lo, float hi) { f32x2_t v = {lo, hi}; bf16x2_t b = __builtin_convertvector(v, bf16x2_t); return __builtin_bit_cast(unsigned, b); }
__device__ __forceinline__ u32x4 pack8(f32x4 a, f32x4 b) { u32x4 w; w.x = cvtpk(a[0], a[1]); w.y = cvtpk(a[2], a[3]); w.z = cvtpk(b[0], b[1]); w.w = cvtpk(b[2], b[3]); return w; }
__device__ __forceinline__ void unpack8(u32x4 w, f32x4& a, f32x4& b) {
    a[0] = __uint_as_float(w.x << 16); a[1] = __uint_as_float(w.x & 0xffff0000u); a[2] = __uint_as_float(w.y << 16); a[3] = __uint_as_float(w.y & 0xffff0000u);
    b[0] = __uint_as_float(w.z << 16); b[1] = __uint_as_float(w.z & 0xffff0000u); b[2] = __uint_as_float(w.w << 16); b[3] = __uint_as_float(w.w & 0xffff0000u); }
__device__ __forceinline__ float fsigmoid(float x) { return __builtin_amdgcn_rcpf(1.0f + __builtin_amdgcn_exp2f(-x * L2E)); }
__device__ __forceinline__ f32x4 sig4(f32x4 x) { f32x4 r; r[0] = fsigmoid(x[0]); r[1] = fsigmoid(x[1]); r[2] = fsigmoid(x[2]); r[3] = fsigmoid(x[3]); return r; }
__device__ __forceinline__ float dot4(f32x4 a) { return (a[0] * a[0] + a[1] * a[1]) + (a[2] * a[2] + a[3] * a[3]); }

namespace pg8 {
constexpr int BM = 256, BK = 64, HALF = 128, HTB = HALF * BK * 2, STAGE_BYTES = 8 * HTB, NXCD = 8, WGM = 8;
__host__ __device__ __forceinline__ int lds_byte(int r, int c) { const int st = (r >> 4) * 2 + (c >> 5), rr = r & 15, cc = c & 31, ob = rr * 64 + cc * 2; return st * 1024 + (ob ^ (((ob >> 9) & 1) << 5)); }
__host__ __device__ __forceinline__ void stage_rc(int b, int& R, int& C) { const int st = b / 1024, sb = b % 1024, swz = sb ^ (((sb >> 9) & 1) << 5); R = (st >> 1) * 16 + swz / 64; C = (st & 1) * 32 + (swz % 64) / 2; }
__host__ __device__ __forceinline__ int perm32(int rho) { const int n = rho >> 4, i = rho & 15; return 8 * (i >> 2) + 4 * n + (i & 3); }

struct Unit { int pm, pn; };
struct Gemm { const bf16_t* A; const bf16_t* Bt; int lda, ldb, M, N, K; };

struct StaticOrder {
    int nM, nN, nwg, G, c;
    __host__ __device__ void init(int M, int N, int G_, int c_) { nM = M / BM; nN = N / BM; nwg = nM * nN; G = G_; c = c_; }
    __host__ __device__ bool next(int i, Unit& u) const {
        const long L = (long)i * G + c; if (L >= nwg) return false;
        int wgid = (int)L; { const int q = nwg / NXCD, r = nwg % NXCD, xcd = wgid % NXCD, off = wgid / NXCD; wgid = (xcd < r ? xcd * (q + 1) : r * (q + 1) + (xcd - r) * q) + off; }
        const int nig = WGM * nN, gid = wgid / nig, fm = gid * WGM, gsz = (nM - fm) < WGM ? (nM - fm) : WGM;
        u.pm = fm + ((wgid % nig) % gsz); u.pn = (wgid % nig) / gsz; return true;
    }
};

enum { EM_SWIGLU = 0, EM_RES = 1, EM_QKV = 2, EM_GATE = 3, EM_MERGE = 4, EM_STORE = 5, EM_PLE = 6 };
struct Epi {
    static constexpr bool PERM = true;
    int mode; int flag; float scale;
    const GAS float* ssq_in; GAS float* ssq_out; GAS float* h; GAS bf16_t* o16; GAS float* mf; const GAS bf16_t* g16;
    const GAS bf16_t* hin; GAS bf16_t* lo; int fin;
    const GAS float *gfox, *gdiff, *cosT, *sinT, *bfg; GAS float* logf;

    __device__ __forceinline__ void operator()(const f32x4 (&acc)[2][2][4][2], const Unit& u, int wr, int wc, int fr, int fq) const {
        const int rowb = u.pm * BM + wr * 64 + fr;
        float rsv[2][4];
#pragma unroll
        for (int ai = 0; ai < 2; ++ai)
#pragma unroll
            for (int m = 0; m < 4; ++m) rsv[ai][m] = ssq_in[rowb + ai * HALF + m * 16];
        if (mode == EM_SWIGLU) {
            const int colh = u.pn * 128 + wc * 32 + fq * 8;
#pragma unroll
            for (int ai = 0; ai < 2; ++ai)
#pragma unroll
                for (int m = 0; m < 4; ++m) {
                    const int row = rowb + ai * HALF + m * 16;
                    const float rstd = __builtin_amdgcn_rsqf(rsv[ai][m] * (1.0f / DM) + EPS);
                    f32x4 o[2];
#pragma unroll
                    for (int n = 0; n < 2; ++n) { const f32x4 a = acc[ai][0][m][n] * rstd, g = acc[ai][1][m][n] * rstd; o[n] = a * sig4(a) * g; }
                    *(GAS u32x4*)(o16 + (size_t)row * DFF + colh) = pack8(o[0], o[1]);
                }
        } else if (mode == EM_RES || mode == EM_PLE) {
            u32x4 hwv[2], lwv[2], twv[2];
#define EPI_LD(B_, J_) do { const int row_ = rowb + ((J_) >> 3) * HALF + (((J_) >> 1) & 3) * 16; \
                const size_t off_ = (size_t)row_ * DM + u.pn * BM + ((J_) & 1) * HALF + wc * 32 + fq * 8; \
                hwv[B_] = *(const GAS u32x4*)(hin + off_); lwv[B_] = *(const GAS u32x4*)(lo + off_); twv[B_] = (mode == EM_PLE) ? *(const GAS u32x4*)(g16 + off_) : u32x4{}; } while (0)
            EPI_LD(0, 0);
            float ss = 0.f;
#pragma unroll
            for (int j = 0; j < 16; ++j) {
                const int ai = j >> 3, m = (j >> 1) & 3, bj = j & 1, cb = j & 1;
                if (j < 15) EPI_LD(cb ^ 1, j + 1);
                const int row = rowb + ai * HALF + m * 16;
                float rstd = 1.f; if (mode == EM_PLE) rstd = __builtin_amdgcn_rsqf(rsv[ai][m] * (1.0f / DM) + EPS);
                const size_t off = (size_t)row * DM + u.pn * BM + bj * HALF + wc * 32 + fq * 8;
                f32x4 h0, h1, l0, l1, t0, t1; unpack8(hwv[cb], h0, h1); unpack8(lwv[cb], l0, l1); unpack8(twv[cb], t0, t1);
                h0 += l0; h1 += l1;
                if (mode == EM_PLE) { h0 += sig4(acc[ai][bj][m][0] * rstd) * t0; h1 += sig4(acc[ai][bj][m][1] * rstd) * t1; }
                else { h0 += acc[ai][bj][m][0] * scale; h1 += acc[ai][bj][m][1] * scale; }
                if (fin) { *(GAS f32x4*)(h + off) = h0; *(GAS f32x4*)(h + off + 4) = h1; }
                const u32x4 hw = pack8(h0, h1); f32x4 g0, g1; unpack8(hw, g0, g1);
                *(GAS u32x4*)(o16 + off) = hw;
                *(GAS u32x4*)(lo + off) = pack8(h0 - g0, h1 - g1);
                ss += dot4(h0) + dot4(h1);
                if (bj == 1) {
                    ss += __shfl_xor(ss, 16); ss += __shfl_xor(ss, 32);
                    if (fq == 0) (void)__hip_atomic_fetch_add(ssq_out + row, ss, __ATOMIC_RELAXED, __HIP_MEMORY_SCOPE_AGENT);
                    ss = 0.f;
                }
            }
#undef EPI_LD
        } else if (mode == EM_QKV) {
            const int T = u.pn;
            if (T == 12) {
                if (wc == 0 && fq == 0) {
                    const f32x4 bf = *(const GAS f32x4*)bfg;
#pragma unroll
                    for (int ai = 0; ai < 2; ++ai)
#pragma unroll
                        for (int m = 0; m < 4; ++m) {
                            const int row = rowb + ai * HALF + m * 16;
                            const float rstd = __builtin_amdgcn_rsqf(rsv[ai][m] * (1.0f / DM) + EPS);
                            const f32x4 v = acc[ai][0][m][0] * rstd + bf; f32x4 o;
#pragma unroll
                            for (int i = 0; i < 4; ++i) o[i] = (fminf(v[i], 0.f) * L2E - __builtin_amdgcn_logf(1.0f + __builtin_amdgcn_exp2f(-fabsf(v[i]) * L2E)));
                            *(GAS f32x4*)(logf + (size_t)row * 4) = o;
                        }
                }
                return;
            }
            const bool do_norm = (T == 3 || T == 4 || (T >= 6 && T <= 9)), do_rope = (T >= 6 && T <= 9);
            const GAS float* gain = (T == 3) ? gfox : (T == 4) ? gfox + 64 : (T == 6 || T == 7) ? gdiff : gdiff + 64;
            const float sc = (T == 0 || T == 3 || T == 6 || T == 7) ? C2 : 1.0f;
            f32x4 gv[2][2];
#pragma unroll
            for (int bj = 0; bj < 2; ++bj)
#pragma unroll
                for (int n = 0; n < 2; ++n) gv[bj][n] = do_norm ? *(const GAS f32x4*)(gain + 32 * bj + 8 * fq + 4 * n) : (f32x4){1.f, 1.f, 1.f, 1.f};
#pragma unroll
            for (int ai = 0; ai < 2; ++ai)
#pragma unroll
                for (int m = 0; m < 4; ++m) {
                    const int row = rowb + ai * HALF + m * 16;
                    const float rstd = __builtin_amdgcn_rsqf(rsv[ai][m] * (1.0f / DM) + EPS);
                    f32x4 x[2][2];
#pragma unroll
                    for (int bj = 0; bj < 2; ++bj)
#pragma unroll
                        for (int n = 0; n < 2; ++n) x[bj][n] = acc[ai][bj][m][n] * rstd;
                    if (do_norm) {
                        float ss = (dot4(x[0][0]) + dot4(x[0][1])) + (dot4(x[1][0]) + dot4(x[1][1]));
                        ss += __shfl_xor(ss, 16); ss += __shfl_xor(ss, 32);
                        const float rn = __builtin_amdgcn_rsqf(ss * (1.0f / 64.0f) + EPS);
#pragma unroll
                        for (int bj = 0; bj < 2; ++bj)
#pragma unroll
                            for (int n = 0; n < 2; ++n) x[bj][n] = x[bj][n] * rn * gv[bj][n];
                    }
                    if (do_rope) {
#pragma unroll
                        for (int n = 0; n < 2; ++n) {
                            f32x4 pr; pr[0] = __shfl_xor(x[0][n][0], 16); pr[1] = __shfl_xor(x[0][n][1], 16); pr[2] = __shfl_xor(x[0][n][2], 16); pr[3] = __shfl_xor(x[0][n][3], 16);
                            const f32x4 c = *(const GAS f32x4*)(cosT + (size_t)row * 8 + 4 * n), s = *(const GAS f32x4*)(sinT + (size_t)row * 8 + 4 * n);
                            if (fq == 0) x[0][n] = x[0][n] * c - pr * s; else if (fq == 1) x[0][n] = x[0][n] * c + pr * s;
                        }
                    }
#pragma unroll
                    for (int bj = 0; bj < 2; ++bj)
                        *(GAS u32x4*)(o16 + (size_t)row * NQKV + T * 256 + wc * 64 + bj * 32 + fq * 8) = pack8(x[bj][0] * sc, x[bj][1] * sc);
                }
        } else if (mode == EM_MERGE) {
            GAS bf16_t* mf16 = (GAS bf16_t*)mf;
            u32x4 gwv[2][2], awv[2][2];
#define EPI_LD(B_, K_) do { const int row_ = rowb + ((K_) >> 2) * HALF + ((K_) & 3) * 16; _Pragma("unroll") for (int bj_ = 0; bj_ < 2; ++bj_) { \
                const size_t off_ = (size_t)row_ * DM + u.pn * BM + bj_ * HALF + wc * 32 + fq * 8; \
                gwv[B_][bj_] = *(const GAS u32x4*)(g16 + off_); awv[B_][bj_] = *(const GAS u32x4*)(mf16 + off_); } } while (0)
            EPI_LD(0, 0);
#pragma unroll
            for (int k = 0; k < 8; ++k) {
                const int ai = k >> 2, m = k & 3, cb = k & 1;
                if (k < 7) EPI_LD(cb ^ 1, k + 1);
                const int row = rowb + ai * HALF + m * 16;
#pragma unroll
                for (int bj = 0; bj < 2; ++bj) {
                    const size_t off = (size_t)row * DM + u.pn * BM + bj * HALF + wc * 32 + fq * 8;
                    f32x4 g0, g1, a0, a1; unpack8(gwv[cb][bj], g0, g1); unpack8(awv[cb][bj], a0, a1);
                    f32x4 v0 = g0 * acc[ai][bj][m][0], v1 = g1 * acc[ai][bj][m][1];
                    if (flag > 0) { v0 += a0; v1 += a1; }
                    if (flag < 2) *(GAS u32x4*)(mf16 + off) = pack8(v0, v1);
                    else *(GAS u32x4*)(o16 + off) = pack8(v0, v1);
                }
            }
#undef EPI_LD
        } else {
#pragma unroll
            for (int ai = 0; ai < 2; ++ai)
#pragma unroll
                for (int m = 0; m < 4; ++m) {
                    const int row = rowb + ai * HALF + m * 16;
                    float rstd = 1.f; if (mode == EM_GATE) rstd = __builtin_amdgcn_rsqf(rsv[ai][m] * (1.0f / DM) + EPS);
#pragma unroll
                    for (int bj = 0; bj < 2; ++bj) {
                        const size_t off = (size_t)row * DM + u.pn * BM + bj * HALF + wc * 32 + fq * 8;
                        if (mode == EM_GATE) { *(GAS u32x4*)(o16 + off) = pack8(sig4(acc[ai][bj][m][0] * rstd), sig4(acc[ai][bj][m][1] * rstd)); }
                        else { *(GAS u32x4*)(o16 + off) = pack8(acc[ai][bj][m][0], acc[ai][bj][m][1]); }
                    }
                }
        }
    }
};

__device__ __forceinline__ void gemm_phase(LAS unsigned char* lds, const Gemm g, const StaticOrder& S, const Epi& E) {
    int tid_ = threadIdx.x; asm volatile("" : "+v"(tid_));
    const int tid = tid_, wid = __builtin_amdgcn_readfirstlane(tid >> 6), lane = tid & 63, wr = wid >> 2, wc = wid & 3, fr = lane & 15, fq = lane >> 4;
    const int K = g.K, nt = K / BK;
    unsigned voffA[2], voffB[2];
#pragma unroll
    for (int i = 0; i < 2; ++i) { int R, C; stage_rc(tid * 16 + i * 8192, R, C); const int Rb = ((R & ~31) + perm32(R & 31));
        voffA[i] = (unsigned)(R * g.lda + C) * 2u; voffB[i] = (unsigned)(Rb * g.ldb + C) * 2u; }
    const size_t kstep = (size_t)(BK * 2);
    const size_t hstepA = (size_t)HALF * g.lda * 2, hstepB = (size_t)HALF * g.ldb * 2;
    const size_t tstepA = 2 * hstepA, tstepB = 2 * hstepB;
    const unsigned ldsw = (unsigned)wid * 1024u;
    const int aoff = lds_byte(wr * 64 + fr, fq * 8), boff = lds_byte(wc * 32 + fr, fq * 8);
#define PG8_SA(b, h) (((b) * 2 + (h)) * HTB)
#define PG8_SB(b, h) ((4 + (b) * 2 + (h)) * HTB)
#define PG8_STAGE(bufoff, gbase, voff) do { _Pragma("unroll") for (int _i = 0; _i < 2; ++_i) \
        __builtin_amdgcn_global_load_lds((const unsigned*)((const char*)(gbase) + (voff)[_i]), (LAS unsigned*)(lds + (bufoff) + ldsw + _i * 8192), 16, 0, 0); } while (0)
#define PG8_LDA(dst, b, h) do { _Pragma("unroll") for (int m = 0; m < 4; ++m) _Pragma("unroll") for (int k = 0; k < 2; ++k) dst[m][k] = *(const LAS bf16x8*)(lds + PG8_SA(b, h) + aoff + m * 2048 + k * 1024); } while (0)
#define PG8_LDB(dst, b, h) do { _Pragma("unroll") for (int n = 0; n < 2; ++n) _Pragma("unroll") for (int k = 0; k < 2; ++k) dst[n][k] = *(const LAS bf16x8*)(lds + PG8_SB(b, h) + boff + n * 2048 + k * 1024); } while (0)
#define PG8_MMA(ai, bj, At, Bt) do { __builtin_amdgcn_s_setprio(1); _Pragma("unroll") for (int m = 0; m < 4; ++m) _Pragma("unroll") for (int n = 0; n < 2; ++n) _Pragma("unroll") for (int k = 0; k < 2; ++k) \
        acc[ai][bj][m][n] = __builtin_amdgcn_mfma_f32_16x16x32_bf16(Bt[n][k], At[m][k], acc[ai][bj][m][n], 0, 0, 0); __builtin_amdgcn_s_setprio(0); } while (0)
#define PG8_WAIT_V(n) asm volatile("s_waitcnt vmcnt(" #n ")" ::: "memory")
#define PG8_WAIT_L(n) asm volatile("s_waitcnt lgkmcnt(" #n ")" ::: "memory")
#define PG8_BAR __builtin_amdgcn_s_barrier()
#define PG8_SCHED __builtin_amdgcn_sched_barrier(0)
    Unit cur, nxt; int ui = 0;
    if (!S.next(0, cur)) return;
    f32x4 acc[2][2][4][2];
#pragma unroll
    for (int a = 0; a < 2; ++a)
#pragma unroll
        for (int b = 0; b < 2; ++b)
#pragma unroll
            for (int m = 0; m < 4; ++m)
#pragma unroll
                for (int n = 0; n < 2; ++n) acc[a][b][m][n] = (f32x4){0.f, 0.f, 0.f, 0.f};
    bf16x8 At[4][2], B0[2][2], B1[2][2];
    const char* cA = (const char*)g.A + (size_t)cur.pm * tstepA; const char* cB = (const char*)g.Bt + (size_t)cur.pn * tstepB;
    PG8_STAGE(PG8_SB(0, 0), cB, voffB); PG8_STAGE(PG8_SB(0, 1), cB + hstepB, voffB); PG8_STAGE(PG8_SA(0, 0), cA, voffA); PG8_STAGE(PG8_SA(0, 1), cA + hstepA, voffA);
    if (wr == 1) PG8_BAR;
    PG8_WAIT_V(2); PG8_BAR;
    PG8_STAGE(PG8_SB(1, 0), cB + kstep, voffB); PG8_STAGE(PG8_SA(1, 0), cA + kstep, voffA); PG8_STAGE(PG8_SB(1, 1), cB + hstepB + kstep, voffB);
    PG8_WAIT_V(6); PG8_BAR;
    for (;;) {
        const bool has_next = S.next(ui + 1, nxt);
        const char* nA = has_next ? (const char*)g.A + (size_t)nxt.pm * tstepA : cA; const char* nB = has_next ? (const char*)g.Bt + (size_t)nxt.pn * tstepB : cB;
        for (int t = 0; t < nt; t += 2) {
            const bool last = (t == nt - 2);
            const char* a1 = cA + (size_t)(t + 1) * kstep;
            const char* a2 = last ? nA : cA + (size_t)(t + 2) * kstep; const char* b2 = last ? nB : cB + (size_t)(t + 2) * kstep;
            const char* a3 = a2 + kstep; const char* b3 = b2 + kstep;
            PG8_LDB(B0, 0, 0); PG8_LDB(B1, 0, 1); PG8_SCHED; PG8_LDA(At, 0, 0); PG8_STAGE(PG8_SA(1, 1), a1 + hstepA, voffA);
            PG8_WAIT_V(8); PG8_WAIT_L(0); PG8_BAR; PG8_MMA(0, 0, At, B0); PG8_MMA(0, 1, At, B1); PG8_BAR; PG8_SCHED;
            PG8_LDA(At, 0, 1); PG8_STAGE(PG8_SB(0, 0), b2, voffB); PG8_STAGE(PG8_SB(0, 1), b2 + hstepB, voffB); PG8_STAGE(PG8_SA(0, 0), a2, voffA);
            PG8_WAIT_V(8); PG8_WAIT_L(0); PG8_BAR; PG8_MMA(1, 0, At, B0); PG8_MMA(1, 1, At, B1); PG8_BAR; PG8_SCHED;
            PG8_LDB(B0, 1, 0); PG8_LDB(B1, 1, 1); PG8_SCHED; PG8_LDA(At, 1, 0); PG8_STAGE(PG8_SA(0, 1), a2 + hstepA, voffA);
            PG8_WAIT_V(8); PG8_WAIT_L(0); PG8_BAR; PG8_MMA(0, 0, At, B0); PG8_MMA(0, 1, At, B1); PG8_BAR; PG8_SCHED;
            PG8_LDA(At, 1, 1); PG8_STAGE(PG8_SB(1, 0), b3, voffB); PG8_STAGE(PG8_SB(1, 1), b3 + hstepB, voffB); PG8_STAGE(PG8_SA(1, 0), a3, voffA);
            PG8_WAIT_V(8); PG8_WAIT_L(0); PG8_BAR; PG8_MMA(1, 0, At, B0); PG8_MMA(1, 1, At, B1); PG8_BAR; PG8_SCHED;
        }
        if (wr == 0) PG8_BAR;
        E(acc, cur, wr, wc, fr, fq);
        if (!has_next) break;
#pragma unroll
        for (int a = 0; a < 2; ++a)
#pragma unroll
            for (int b = 0; b < 2; ++b)
#pragma unroll
                for (int m = 0; m < 4; ++m)
#pragma unroll
                    for (int n = 0; n < 2; ++n) acc[a][b][m][n] = (f32x4){0.f, 0.f, 0.f, 0.f};
        cur = nxt; cA = nA; cB = nB; ++ui;
        if (wr == 1) PG8_BAR;
    }
    PG8_WAIT_V(0);
    PG8_BAR;
#undef PG8_SA
#undef PG8_SB
#undef PG8_STAGE
#undef PG8_LDA
#undef PG8_LDB
#undef PG8_MMA
#undef PG8_WAIT_V
#undef PG8_WAIT_L
#undef PG8_BAR
#undef PG8_SCHED
}
}

namespace att {
constexpr int PITCH = NQKV, AOP = DM;
constexpr int LK = 0, LV = 16384, LWS = 65536, LOST = 67584, LCUM = LOST + 32768, LMISC = 133120;
__device__ __forceinline__ int crow(int r, int hi) { return (r & 3) + 8 * (r >> 2) + 4 * hi; }
__device__ __forceinline__ float partner32(float x, int hi) { auto rr = __builtin_amdgcn_permlane32_swap(__float_as_uint(x), __float_as_uint(x), false, false); return __uint_as_float(hi ? rr[0] : rr[1]); }
__device__ __forceinline__ float rowmax(const f32x16& p0, const f32x16& p1) {
    float a = fmaxf(fmaxf(p0[0], p0[1]), p1[0]), b = fmaxf(fmaxf(p0[2], p0[3]), p1[1]); a = fmaxf(fmaxf(a, p1[2]), p1[3]);
#pragma unroll
    for (int r = 4; r < 16; r += 4) { a = fmaxf(fmaxf(a, p0[r]), p0[r + 1]); b = fmaxf(fmaxf(b, p0[r + 2]), p0[r + 3]); a = fmaxf(fmaxf(a, p1[r]), p1[r + 1]); b = fmaxf(fmaxf(b, p1[r + 2]), p1[r + 3]); }
    const float m = fmaxf(a, b);
    auto rr = __builtin_amdgcn_permlane32_swap(__float_as_uint(m), __float_as_uint(m), false, false);
    return fmaxf(__uint_as_float(rr[0]), __uint_as_float(rr[1]));
}
__device__ __forceinline__ void qkt(f32x16& p0, f32x16& p1, const LAS char* kb, const bf16x8* qr, const f32x16& cinit) {
#pragma unroll
    for (int d0 = 0; d0 < 4; ++d0) {
        const bf16x8 b0 = *(const LAS bf16x8*)(kb + d0 * 2048);
        const bf16x8 b1 = *(const LAS bf16x8*)(kb + d0 * 2048 + 512);
        if (d0 == 0) { p0 = __builtin_amdgcn_mfma_f32_32x32x16_bf16(b0, qr[0], cinit, 0, 0, 0); p1 = __builtin_amdgcn_mfma_f32_32x32x16_bf16(b1, qr[0], cinit, 0, 0, 0); }
        else { p0 = __builtin_amdgcn_mfma_f32_32x32x16_bf16(b0, qr[d0], p0, 0, 0, 0); p1 = __builtin_amdgcn_mfma_f32_32x32x16_bf16(b1, qr[d0], p1, 0, 0, 0); }
    }
}
__device__ __forceinline__ void pv(f32x16* o, int vb, bf16x8 pa0, bf16x8 pa1, bf16x8 pa2, bf16x8 pa3) {
    s16x4 lo[2][4], hi[2][4];
#pragma unroll
    for (int d0 = 0; d0 < 2; ++d0)
#pragma unroll
        for (int ks = 0; ks < 4; ++ks) {
            asm volatile("ds_read_b64_tr_b16 %0,%1 offset:%c2" : "=&v"(lo[d0][ks]) : "v"(vb), "i"(d0 * 4096 + ks * 1024) : "memory");
            asm volatile("ds_read_b64_tr_b16 %0,%1 offset:%c2" : "=&v"(hi[d0][ks]) : "v"(vb), "i"(d0 * 4096 + ks * 1024 + 512) : "memory"); }
    asm volatile("s_waitcnt lgkmcnt(0)" ::: "memory"); __builtin_amdgcn_sched_barrier(0);
#define PK(d, k) (bf16x8){lo[d][k][0], lo[d][k][1], lo[d][k][2], lo[d][k][3], hi[d][k][0], hi[d][k][1], hi[d][k][2], hi[d][k][3]}
    o[0] = __builtin_amdgcn_mfma_f32_32x32x16_bf16(pa0, PK(0, 0), o[0], 0, 0, 0); o[1] = __builtin_amdgcn_mfma_f32_32x32x16_bf16(pa0, PK(1, 0), o[1], 0, 0, 0);
    o[0] = __builtin_amdgcn_mfma_f32_32x32x16_bf16(pa1, PK(0, 1), o[0], 0, 0, 0); o[1] = __builtin_amdgcn_mfma_f32_32x32x16_bf16(pa1, PK(1, 1), o[1], 0, 0, 0);
    o[0] = __builtin_amdgcn_mfma_f32_32x32x16_bf16(pa2, PK(0, 2), o[0], 0, 0, 0); o[1] = __builtin_amdgcn_mfma_f32_32x32x16_bf16(pa2, PK(1, 2), o[1], 0, 0, 0);
    o[0] = __builtin_amdgcn_mfma_f32_32x32x16_bf16(pa3, PK(0, 3), o[0], 0, 0, 0); o[1] = __builtin_amdgcn_mfma_f32_32x32x16_bf16(pa3, PK(1, 3), o[1], 0, 0, 0);
#undef PK
}

template <int MODE, bool NOMAX = false>
__device__ __forceinline__ void attn_unit(int b, int h, int qb, const GAS bf16_t* __restrict__ QKV, GAS bf16_t* __restrict__ AO, const GAS float* __restrict__ logf,
                                          const GAS float* __restrict__ subln, float lam, float oscale, LAS unsigned char* shm) {
    constexpr int DV = (MODE == 2) ? 128 : 64, NPASS = (MODE == 2) ? 2 : 1, ND = DV / 32;
    int tid_ = threadIdx.x; asm volatile("" : "+v"(tid_));
    const int tid = tid_, lane = tid & 63, r32 = lane & 31, hi = lane >> 5; const int wid = __builtin_amdgcn_readfirstlane(tid >> 6);
    const long rowbase = (long)b * SEQ; const int q0 = qb * 256;
    const int qcol = MODE == 0 ? h * 64 : MODE == 1 ? 768 + h * 64 : 1536 + h * 128;
    const int kcol = MODE == 0 ? 256 + h * 64 : MODE == 1 ? 1024 + h * 64 : 2048 + h * 128;
    const int vcol = MODE == 0 ? 512 + h * 64 : MODE == 1 ? 1280 + h * 64 : 2560 + h * 128;
    const int ocol = MODE == 0 ? h * 64 : MODE == 1 ? 256 + h * 64 : 512 + h * 128;
    const int NT = 4 * qb + 4, ktmax_w = 4 * qb + (wid >> 1);
    const unsigned lds0 = (unsigned)(uintptr_t)shm;
    LAS float* wsf = (LAS float*)(shm + LWS) + wid * 64;
    LAS float* cum = (LAS float*)(shm + LCUM);
    const int trel = 32 * (wid & 1) + r32;
    float cq = 0.f; int it0 = 0;
    if (MODE == 1) {
        const int n = q0 + 256, base = tid * 8; float v[8];
#pragma unroll
        for (int i = 0; i < 8; ++i) { const int s = base + i; v[i] = (s < n) ? logf[(size_t)(rowbase + s) * 4 + h] : 0.f; }
#pragma unroll
        for (int i = 1; i < 8; ++i) v[i] += v[i - 1];
        float inc = v[7];
#pragma unroll
        for (int o = 1; o < 64; o <<= 1) { const float t = __shfl_up(inc, o); if (lane >= o) inc += t; }
        LAS float* wt = (LAS float*)(shm + LMISC) + 16;
        if (lane == 63) wt[wid] = inc;
        __syncthreads();
        float woff = 0.f;
#pragma unroll
        for (int w = 0; w < 8; ++w) woff += (w < wid) ? wt[w] : 0.f;
        const float toff = woff + inc - v[7];
#pragma unroll
        for (int i = 0; i < 8; ++i) cum[base + i] = v[i] + toff;
        __syncthreads();
        cq = cum[q0 + wid * 32 + r32];
        float gq = fabsf(subln[lane]), gk = fabsf(subln[64 + lane]);
#pragma unroll
        for (int o = 1; o < 64; o <<= 1) { gq = fmaxf(gq, __shfl_xor(gq, o)); gk = fmaxf(gk, __shfl_xor(gk, o)); }
        const float Bb = 64.0f * C2 * gq * gk * 1.03f + 1.0f, thr = -(2.0f * Bb + 150.0f), c0 = cum[q0];
        while (it0 < NT - 4 && (c0 - cum[64 * it0 + 63]) < thr) ++it0;
        it0 = __builtin_amdgcn_readfirstlane(it0);
    }
    GAS bf16_t* Ow = AO + (size_t)(rowbase + q0 + wid * 32) * AOP + ocol;
    LAS bf16_t* stg = (LAS bf16_t*)(shm + LOST) + wid * (DV * 32);
#pragma unroll
    for (int pass = 0; pass < NPASS; ++pass) {
        const GAS bf16_t* Qw = QKV + (size_t)(rowbase + q0 + wid * 32) * PITCH + qcol + pass * 64;
        const GAS bf16_t* ksrc = QKV + (size_t)(rowbase + lane) * PITCH + kcol + pass * 64 + wid * 8;
        const GAS bf16_t* vsrc = QKV + (size_t)(rowbase + 16 * (wid & 3) + (lane >> 2)) * PITCH + vcol + (wid >> 2) * 32 + (lane & 3) * 8;
        bf16x8 qr[4];
#pragma unroll
        for (int d0 = 0; d0 < 4; ++d0) qr[d0] = *(const GAS bf16x8*)(Qw + (size_t)r32 * PITCH + d0 * 16 + hi * 8);
        float mhat = 0.f, l_reg = 0.f, carry = 0.f;
        f32x16 o[ND];
#pragma unroll
        for (int d = 0; d < ND; ++d) o[d] = f32x16{};
        u32x4 kreg, vreg0, vreg1 = u32x4{};
        { const int kt = (MODE == 0) ? NT - 1 : it0; const size_t go = (size_t)kt * 64 * PITCH;
          kreg = *(const GAS u32x4*)(ksrc + go); vreg0 = *(const GAS u32x4*)(vsrc + go); if (DV == 128) vreg1 = *(const GAS u32x4*)(vsrc + go + 64); }
        u32x4 pw0 = u32x4{}, pw1 = u32x4{}, pw2 = u32x4{}, pw3 = u32x4{};
        const bool lag = (wid >= 4); bool pend = false; int vs = 0, vsp = 0;
        const int vbl = (int)(lds0 + LV) + ((lane >> 4) & 1) * 32 + (lane & 3) * 8 + (4 * hi + ((lane & 15) >> 2)) * 64;
#define ATT_PV(VB_) do { pv(o, (VB_), __builtin_bit_cast(bf16x8, pw0), __builtin_bit_cast(bf16x8, pw1), __builtin_bit_cast(bf16x8, pw2), __builtin_bit_cast(bf16x8, pw3)); \
            if (DV == 128) pv(o + 2, (VB_) + 8192, __builtin_bit_cast(bf16x8, pw0), __builtin_bit_cast(bf16x8, pw1), __builtin_bit_cast(bf16x8, pw2), __builtin_bit_cast(bf16x8, pw3)); } while (0)
        {   *(LAS u32x4*)(shm + LK + (it0 & 1) * 8192 + wid * 1024 + lane * 16) = kreg;
            *(LAS u32x4*)(shm + LV + wid * 1024 + lane * 16) = vreg0;
            if (DV == 128) *(LAS u32x4*)(shm + LV + 8192 + wid * 1024 + lane * 16) = vreg1;
            const int kt1 = (MODE == 0) ? NT - 2 - it0 : it0 + 1; const size_t go = (size_t)kt1 * 64 * PITCH;
            kreg = *(const GAS u32x4*)(ksrc + go); vreg0 = *(const GAS u32x4*)(vsrc + go); if (DV == 128) vreg1 = *(const GAS u32x4*)(vsrc + go + 64); }
        for (int it = it0; it < NT; ++it) {
            const int kt = (MODE == 0) ? NT - 1 - it : it, slot = it & 1;
            const int vsn = (vs == 2) ? 0 : vs + 1;
            __syncthreads();
            if (it + 1 < NT) {
                *(LAS u32x4*)(shm + LK + (slot ^ 1) * 8192 + wid * 1024 + lane * 16) = kreg;
                *(LAS u32x4*)(shm + LV + vsn * 16384 + wid * 1024 + lane * 16) = vreg0;
                if (DV == 128) *(LAS u32x4*)(shm + LV + vsn * 16384 + 8192 + wid * 1024 + lane * 16) = vreg1; }
            if (it + 2 < NT) { const int ktn = (MODE == 0) ? kt - 2 : kt + 2; const size_t go = (size_t)ktn * 64 * PITCH;
                kreg = *(const GAS u32x4*)(ksrc + go); vreg0 = *(const GAS u32x4*)(vsrc + go); if (DV == 128) vreg1 = *(const GAS u32x4*)(vsrc + go + 64); }
            if (lag && pend) { ATT_PV(vbl + vsp * 16384); pend = false; }
            bool wdone = false;
            if (kt <= ktmax_w) {
                const LAS char* kb = (const LAS char*)(shm + LK + slot * 8192) + hi * 1024 + r32 * 16;
                const bool diag = (kt == ktmax_w);
                f32x16 p0, p1;
                if (MODE == 0) {
                    f32x16 cz = f32x16{}; asm volatile("" : "+v"(cz));
                    qkt(p0, p1, kb, qr, cz);
                    f32x16 L0, L1;
#pragma unroll
                    for (int r = 0; r < 16; ++r) {
                        const float z0 = p0[r], z1 = p1[r];
                        L0[r] = -__builtin_amdgcn_logf(1.0f + __builtin_amdgcn_exp2f(-z0)) - z0;
                        L1[r] = -__builtin_amdgcn_logf(1.0f + __builtin_amdgcn_exp2f(-z1)) - z1;
                    }
                    if (diag) {
#pragma unroll
                        for (int r = 0; r < 16; ++r) { const int kv = crow(r, hi);
                            if (kv >= trel) { L0[r] = 0.f; p0[r] = -INFINITY; }
                            if (kv + 32 >= trel) { L1[r] = 0.f; p1[r] = -INFINITY; } }
                    }
                    float T0[4], T1[4], PG0[4], PG1[4];
#pragma unroll
                    for (int g = 0; g < 4; ++g) {
                        const float g0 = (L0[4 * g] + L0[4 * g + 1]) + (L0[4 * g + 2] + L0[4 * g + 3]), g1 = (L1[4 * g] + L1[4 * g + 1]) + (L1[4 * g + 2] + L1[4 * g + 3]);
                        PG0[g] = partner32(g0, hi); PG1[g] = partner32(g1, hi); T0[g] = g0 + PG0[g]; T1[g] = g1 + PG1[g];
                    }
                    const float tot1 = (T1[0] + T1[1]) + (T1[2] + T1[3]), tot0 = (T0[0] + T0[1]) + (T0[2] + T0[3]);
                    float ST1[4], ST0[4];
                    ST1[3] = 0.f; ST1[2] = T1[3]; ST1[1] = ST1[2] + T1[2]; ST1[0] = ST1[1] + T1[1];
                    ST0[3] = tot1; ST0[2] = ST0[3] + T0[3]; ST0[1] = ST0[2] + T0[2]; ST0[0] = ST0[1] + T0[1];
#pragma unroll
                    for (int g = 0; g < 4; ++g) {
                        const float b0 = carry + ST0[g] + (hi == 0 ? PG0[g] : 0.f), b1 = carry + ST1[g] + (hi == 0 ? PG1[g] : 0.f);
                        L0[4 * g + 3] += b0; L0[4 * g + 2] += L0[4 * g + 3]; L0[4 * g + 1] += L0[4 * g + 2]; L0[4 * g] += L0[4 * g + 1];
                        L1[4 * g + 3] += b1; L1[4 * g + 2] += L1[4 * g + 3]; L1[4 * g + 1] += L1[4 * g + 2]; L1[4 * g] += L1[4 * g + 1];
                    }
#pragma unroll
                    for (int r = 0; r < 16; ++r) { p0[r] = __builtin_amdgcn_exp2f(p0[r] + L0[r]); p1[r] = __builtin_amdgcn_exp2f(p1[r] + L1[r]); }
                    carry += tot0 + tot1;
                    wdone = !__any(!(carry < -150.f));
                } else {
                    f32x16 negm;
                    { const float nm = NOMAX ? cq : cq - mhat;
#pragma unroll
                      for (int r = 0; r < 16; ++r) negm[r] = nm; }
                    asm volatile("" : "+v"(negm));
                    qkt(p0, p1, kb, qr, negm);
                    if (MODE == 1) {
#pragma unroll
                        for (int g = 0; g < 4; ++g) {
                            const f32x4 c0 = *(const LAS f32x4*)(cum + kt * 64 + 8 * g + 4 * hi), c1 = *(const LAS f32x4*)(cum + kt * 64 + 32 + 8 * g + 4 * hi);
#pragma unroll
                            for (int i = 0; i < 4; ++i) { p0[4 * g + i] -= c0[i]; p1[4 * g + i] -= c1[i]; }
                        }
                        if (diag) {
#pragma unroll
                            for (int r = 0; r < 16; ++r) { const int kv = crow(r, hi); if (kv > trel) p0[r] = -INFINITY; if (kv + 32 > trel) p1[r] = -INFINITY; }
                        }
                    }
                    const float rm = NOMAX ? 0.f : rowmax(p0, p1);
                    if (NOMAX) {
                    } else if (it == it0) {
                        mhat = rm;
#pragma unroll
                        for (int r = 0; r < 16; ++r) { p0[r] -= rm; p1[r] -= rm; }
                    } else if (__any(rm > 8.0f)) {
                        const float dl = fmaxf(rm, 0.f); mhat += dl;
#pragma unroll
                        for (int r = 0; r < 16; ++r) { p0[r] -= dl; p1[r] -= dl; }
                        const float f = __builtin_amdgcn_exp2f(-dl); l_reg *= f;
                        if (hi == 0) wsf[r32] = f;
                        asm volatile("s_waitcnt lgkmcnt(0)" ::: "memory");
#pragma unroll
                        for (int g = 0; g < 4; ++g) { const f32x4 fv = *(const LAS f32x4*)(wsf + 8 * g + 4 * hi);
#pragma unroll
                            for (int d = 0; d < ND; ++d)
#pragma unroll
                                for (int i = 0; i < 4; ++i) o[d][4 * g + i] *= fv[i]; }
                    }
                    float sacc = 0.f;
#pragma unroll
                    for (int r = 0; r < 16; ++r) { p0[r] = __builtin_amdgcn_exp2f(p0[r]); p1[r] = __builtin_amdgcn_exp2f(p1[r]); sacc += p0[r] + p1[r]; }
                    l_reg += sacc;
                }
                pw0 = (u32x4){cvtpk(p0[0], p0[1]), cvtpk(p0[2], p0[3]), cvtpk(p0[4], p0[5]), cvtpk(p0[6], p0[7])};
                pw1 = (u32x4){cvtpk(p0[8], p0[9]), cvtpk(p0[10], p0[11]), cvtpk(p0[12], p0[13]), cvtpk(p0[14], p0[15])};
                pw2 = (u32x4){cvtpk(p1[0], p1[1]), cvtpk(p1[2], p1[3]), cvtpk(p1[4], p1[5]), cvtpk(p1[6], p1[7])};
                pw3 = (u32x4){cvtpk(p1[8], p1[9]), cvtpk(p1[10], p1[11]), cvtpk(p1[12], p1[13]), cvtpk(p1[14], p1[15])};
                if (!lag) ATT_PV(vbl + vs * 16384); else pend = true;
            }
            vsp = vs; vs = vsn;
            if (MODE == 0) { if (__syncthreads_and(wdone ? 1 : 0)) break; }
        }
        if (lag && pend) ATT_PV(vbl + vsp * 16384);
#undef ATT_PV
        if (MODE != 0) {
            const float lt = l_reg + partner32(l_reg, hi);
            if (hi == 0) wsf[32 + r32] = lt;
            asm volatile("s_waitcnt lgkmcnt(0)" ::: "memory");
#pragma unroll
            for (int g = 0; g < 4; ++g) { const f32x4 lv = *(const LAS f32x4*)(wsf + 32 + 8 * g + 4 * hi);
#pragma unroll
                for (int i = 0; i < 4; ++i) { const float rl = __builtin_amdgcn_rcpf(lv[i]);
#pragma unroll
                    for (int d = 0; d < ND; ++d) o[d][4 * g + i] *= rl; } }
        }
        if (MODE == 2 && pass == 0) {
#pragma unroll
            for (int r = 0; r < 16; ++r) { const int orow = crow(r, hi);
#pragma unroll
                for (int d = 0; d < ND; ++d) stg[orow * DV + d * 32 + r32] = (bf16_t)(cvtpk(o[d][r], 0.f) & 0xffffu); }
        }
        if (MODE == 2 && pass == 1) {
            float ssr[16];
#pragma unroll
            for (int r = 0; r < 16; ++r) ssr[r] = 0.f;
#pragma unroll
            for (int r = 0; r < 16; ++r) { const int orow = crow(r, hi);
#pragma unroll
                for (int d = 0; d < ND; ++d) { const float a0 = __uint_as_float((unsigned)stg[orow * DV + d * 32 + r32] << 16);
                    o[d][r] = a0 - lam * o[d][r]; ssr[r] += o[d][r] * o[d][r]; } }
#pragma unroll
            for (int r = 0; r < 16; ++r) {
#pragma unroll
                for (int x = 1; x < 32; x <<= 1) ssr[r] += __shfl_xor(ssr[r], x);
                ssr[r] = __builtin_amdgcn_rsqf(ssr[r] * (1.0f / 128.0f) + EPS) * oscale;
            }
#pragma unroll
            for (int d = 0; d < ND; ++d) { const float gsl = subln[d * 32 + r32];
#pragma unroll
                for (int r = 0; r < 16; ++r) o[d][r] *= ssr[r] * gsl; }
        }
        if (MODE != 2 || pass == 1) {
#pragma unroll
            for (int r = 0; r < 16; ++r) { const int orow = crow(r, hi);
#pragma unroll
                for (int d = 0; d < ND; ++d) stg[orow * DV + d * 32 + r32] = (bf16_t)(cvtpk(o[d][r], 0.f) & 0xffffu); }
            asm volatile("s_waitcnt lgkmcnt(0)" ::: "memory");
            if (DV == 64) {
#pragma unroll
                for (int i = 0; i < 4; ++i) { const int row = i * 8 + (lane >> 3), ch = lane & 7; const u32x4 v = *(const LAS u32x4*)(stg + row * 64 + ch * 8); *(GAS u32x4*)(Ow + (size_t)row * AOP + ch * 8) = v; }
            } else {
#pragma unroll
                for (int i = 0; i < 8; ++i) { const int row = i * 4 + (lane >> 4), ch = lane & 15; const u32x4 v = *(const LAS u32x4*)(stg + row * 128 + ch * 8); *(GAS u32x4*)(Ow + (size_t)row * AOP + ch * 8) = v; }
            }
        }
        __syncthreads();
    }
}
}

__device__ __forceinline__ float wave_sum(float v) {
#pragma unroll
    for (int o = 1; o < 64; o <<= 1) v += __shfl_xor(v, o);
    return v;
}
struct MatDesc { const float* src; const float* gain; bf16_t* dst; int ldw, K, Np, kind; };
__device__ __forceinline__ void xpose_item(const MatDesc& d, int item, LAS float* scr, int lane) {
    const int nblk = d.Np / 32, kb = item / nblk, nb = item % nblk, k0 = 64 * kb, n0 = 32 * nb;
    int sc = n0, nvalid = 32;
    if (d.kind == 1) { const int tile = n0 >> 8, w = n0 & 255; sc = (w < 128) ? 128 * tile + w : DFF + 128 * tile + (w - 128); }
    else if (d.kind == 2) { const int T = n0 >> 8, w = n0 & 255;
        if (T == 12) { sc = 1536; nvalid = (w == 0) ? 4 : 0; }
        else { const int hh = (w >> 5) & 3, dd = 32 * (w >> 7), L = 256 * T + 64 * hh + dd; sc = (L < 1536) ? L : L + 4; } }
    {
        const int r8 = lane >> 3, q = lane & 7; const bool ok = (4 * q < nvalid);
        f32x4 v[8];
#pragma unroll
        for (int i = 0; i < 8; ++i) v[i] = ok ? *(const f32x4*)(d.src + (size_t)(k0 + 8 * i + r8) * d.ldw + sc + 4 * q) : (f32x4){0.f, 0.f, 0.f, 0.f};
#pragma unroll
        for (int i = 0; i < 8; ++i) { const int kk = 8 * i + r8; const float gm = d.gain ? d.gain[k0 + kk] : 1.f;
            LAS float* sp = scr + kk * 33 + 4 * q; sp[0] = v[i][0] * gm; sp[1] = v[i][1] * gm; sp[2] = v[i][2] * gm; sp[3] = v[i][3] * gm; }
    }
    asm volatile("s_waitcnt lgkmcnt(0)" ::: "memory");
    const int c = lane & 7;
#pragma unroll
    for (int jj = 0; jj < 4; ++jj) { const int n = (lane >> 3) + 8 * jj; const LAS float* s = scr + (8 * c) * 33 + n;
        u32x4 o; o.x = cvtpk(s[0 * 33], s[1 * 33]); o.y = cvtpk(s[2 * 33], s[3 * 33]); o.z = cvtpk(s[4 * 33], s[5 * 33]); o.w = cvtpk(s[6 * 33], s[7 * 33]);
        *(u32x4*)(d.dst + (size_t)(n0 + n) * d.K + k0 + 8 * c) = o; }
    asm volatile("s_waitcnt lgkmcnt(0)" ::: "memory");
}

#define XB_TMO      128
#define XB_XCNT(j)  (256  + 64 * (j))
#define XB_XSUB(j)  (1280 + 64 * (j))
#define XB_XGEN(j)  (2304 + 64 * (j))
#define XB_TOP      3328
#define XB_TOPGEN   3392
#define XCD_BAR_WORDS 3456
#define XB_SPIN_CAP (1u << 18)
__device__ __forceinline__ unsigned xb_ld(unsigned* p)              { return __hip_atomic_load(p, __ATOMIC_RELAXED, __HIP_MEMORY_SCOPE_AGENT); }
__device__ __forceinline__ unsigned xb_add(unsigned* p, unsigned v) { return __hip_atomic_fetch_add(p, v, __ATOMIC_RELAXED, __HIP_MEMORY_SCOPE_AGENT); }
__device__ __forceinline__ unsigned xb_xcc_id() { return (unsigned)__builtin_amdgcn_s_getreg((3 << 11) | 20) & 0xFu; }
#define XB_SPIN(cond, bar) do { unsigned _sp = 0; while (cond) { __builtin_amdgcn_s_sleep(1); \
    if ((++_sp & 255u) == 0u) { if (xb_ld(&(bar)[XB_TMO])) break; if (_sp > XB_SPIN_CAP) { atomicAdd(&(bar)[XB_TMO], 1u); break; } } } } while (0)
struct XcdBarrier { unsigned* bar; unsigned x; volatile LAS unsigned* st; };
__device__ __forceinline__ XcdBarrier xcd_barrier_post(unsigned* bar, volatile LAS unsigned* st) {
    XcdBarrier b; b.bar = bar; b.x = xb_xcc_id(); b.st = st;
    if (threadIdx.x == 0) (void)xb_add(&bar[XB_XCNT(b.x)], 1u);
    return b;
}
__device__ __forceinline__ void xcd_barrier_complete(unsigned* bar, unsigned x, unsigned& nloc, unsigned& nx) {
    const unsigned G = gridDim.x * gridDim.y * gridDim.z;
    unsigned sum, cnt, mine, sp = 0u;
    for (;;) {
        sum = 0u; cnt = 0u; mine = 0u;
#pragma unroll
        for (unsigned j = 0; j < 16; ++j) { const unsigned c = xb_ld(&bar[XB_XCNT(j)]); sum += c; cnt += (c > 0u) ? 1u : 0u; mine = (j == x) ? c : mine; }
        if (sum == G) break;
        __builtin_amdgcn_s_sleep(1);
        if ((++sp & 255u) == 0u) { if (xb_ld(&bar[XB_TMO])) break; if (sp > XB_SPIN_CAP) { atomicAdd(&bar[XB_TMO], 1u); break; } }
    }
    nloc = mine > 0u ? mine : 1u; nx = cnt > 0u ? cnt : 1u;
}
__device__ __forceinline__ void xcd_barrier(unsigned* bar, unsigned x, volatile LAS unsigned* st) {
    asm volatile("s_waitcnt vmcnt(0)" ::: "memory");
    __syncthreads();
    if (threadIdx.x == 0) {
        __builtin_amdgcn_s_waitcnt(0);
        unsigned nloc = st[0], nx = st[1];
        if (nloc == 0u) { xcd_barrier_complete(bar, x, nloc, nx); st[0] = nloc; st[1] = nx; }
        const unsigned old = xb_add(&bar[XB_XSUB(x)], 1u);
        const unsigned gen = old / nloc;
        if (old + 1u == (gen + 1u) * nloc) {
            __builtin_amdgcn_fence(__ATOMIC_RELEASE, "agent");
            asm volatile("s_waitcnt vmcnt(0)" ::: "memory");
            const unsigned og = xb_add(&bar[XB_TOP], 1u);
            const unsigned tg = og / nx;
            if (og + 1u == (tg + 1u) * nx) xb_add(&bar[XB_TOPGEN], 1u);
            else XB_SPIN(xb_ld(&bar[XB_TOPGEN]) == tg, bar);
            __builtin_amdgcn_fence(__ATOMIC_ACQUIRE, "agent");
            xb_add(&bar[XB_XGEN(x)], 1u);
            asm volatile("s_waitcnt vmcnt(0)" ::: "memory");
        } else {
            XB_SPIN(xb_ld(&bar[XB_XGEN(x)]) == gen, bar);
            __builtin_amdgcn_fence(__ATOMIC_ACQUIRE, "agent");
            asm volatile("s_waitcnt vmcnt(0)" ::: "memory");
        }
    }
    __syncthreads();
}
constexpr size_t WS_BAR = 65536;

struct Args { const void* in[21]; float* out; unsigned char* ws; };
struct Desc { const bf16_t* A; const bf16_t* Bt; const float* ssq_in; float* ssq_out; bf16_t* o16; const float* gfox; const float* gdiff; const float* bfg; const float* subln; const float* pl; const bf16_t* hin;
              int lda, ldb, N, K, mode, flag, sync, fin; float scale, lam, oscale, padf; };
template <class T> __device__ __forceinline__ T* uni_ptr(T* p) { const unsigned long long v = (unsigned long long)(uintptr_t)p;
    const unsigned lo = __builtin_amdgcn_readfirstlane((unsigned)v), hi = __builtin_amdgcn_readfirstlane((unsigned)(v >> 32));
    return (T*)(__attribute__((address_space(1))) T*)(uintptr_t)(((unsigned long long)hi << 32) | lo); }
__device__ __forceinline__ int uni_i(int v) { return __builtin_amdgcn_readfirstlane(v); }
__device__ __forceinline__ float uni_f(float v) { return __uint_as_float(__builtin_amdgcn_readfirstlane(__float_as_uint(v))); }
constexpr int EM_ATTN = 7, NSTEP = 15;
constexpr size_t WS_TAB = 4096;

__global__ void __launch_bounds__(512) fwd_megakernel(Args a) {
    extern __shared__ __attribute__((aligned(16))) unsigned char lds_raw[];
    LAS unsigned char* lds = (LAS unsigned char*)lds_raw;
    cg::grid_group grid = cg::this_grid();
    const int tid = threadIdx.x;

    {
        const int lane = tid & 63, wave = __builtin_amdgcn_readfirstlane(tid >> 6);
        const int G = gridDim.x, bx = blockIdx.x;
        unsigned char* ws = a.ws;
        const float* x = (const float*)a.in[0]; const float* pin = (const float*)a.in[1]; const int* positions = (const int*)a.in[2];
        const float* ffn1_norm = (const float*)a.in[3]; const float* ffn1_wi = (const float*)a.in[4]; const float* ffn1_wo = (const float*)a.in[5];
        const float* mix_norm = (const float*)a.in[6]; const float* w_in = (const float*)a.in[7]; const float* b_forget = (const float*)a.in[8];
        const float* qk_gain_fox = (const float*)a.in[9]; const float* qk_gain_diff = (const float*)a.in[10]; const float* diff_lambda = (const float*)a.in[11];
        const float* diff_subln = (const float*)a.in[12]; const float* w_br = (const float*)a.in[13]; const float* w_o = (const float*)a.in[14];
        const float* ffn2_norm = (const float*)a.in[15]; const float* ffn2_wi = (const float*)a.in[16]; const float* ffn2_wo = (const float*)a.in[17];
        const float* ple_norm = (const float*)a.in[18]; const float* ple_gate_w = (const float*)a.in[19]; const float* ple_proj_w = (const float*)a.in[20];
        float* out = a.out;
        unsigned* ctl = (unsigned*)(ws + WS_CTL);
        float* SS = (float*)(ws + WS_SS);
        float* cosT = (float*)(ws + WS_COS); float* sinT = (float*)(ws + WS_SIN);
        bf16_t* Wb = (bf16_t*)(ws + WS_W);
        bf16_t* HB = (bf16_t*)(ws + WS_HB); bf16_t* BIG = (bf16_t*)(ws + WS_BIG); bf16_t* GS = (bf16_t*)(ws + WS_GS); bf16_t* AO = (bf16_t*)(ws + WS_AO); bf16_t* PB = (bf16_t*)(ws + WS_PB);
        bf16_t* M16 = (bf16_t*)(ws + WS_BIG + 128 * MiB);
        const int gw = bx * 8 + wave, NGW = G * 8; const int gt = bx * 512 + tid, NGT = G * 512;
        if (gt < 16) ctl[gt] = 0u;
        if (gt < XCD_BAR_WORDS) ((unsigned*)(ws + WS_BAR))[gt] = 0u;
        if (tid < 2) ((volatile LAS unsigned*)(lds + att::LMISC + 128))[tid] = 0u;
        if (bx == 0 && wave >= 4) {
            const int l = wave - 4; const float* lf = diff_lambda + l * 256;
            const float s1 = wave_sum(lf[lane] * lf[64 + lane]), s2 = wave_sum(lf[128 + lane] * lf[192 + lane]);
            const float lam_init = 0.8f - 0.6f * expf(-0.3f * (float)l);
            if (lane == 0) ((float*)ctl)[16 + l] = expf(s1) - expf(s2) + lam_init;
        }
        if (bx == 0 && tid < NLAYER * NSTEP) {
            Desc* tab = (Desc*)(ws + WS_TAB);
            const int l = tid / NSTEP, st = tid % NSTEP;
            {
                const float lam_init = 0.8f - 0.6f * expf(-0.3f * (float)l);
                bf16_t* WL = Wb + (size_t)l * LAYER_W_ELEMS; float* SSl = SS + (size_t)(4 * l) * MTOK;
                {
                    Desc* d = tab + l * NSTEP + st;
                    const bf16_t* A = HB; const bf16_t* Bt = WL; const float* ssq_in = SSl; float* ssq_out = SSl; bf16_t* o16 = GS;
                    int lda = DM, ldb = DM, N = DM, K = DM, mode = 0, flag = 0, sync = 1; float scale = 1.f;
                    switch (st) {
                        case 0: A = AO; Bt = WL + OW_1I; N = 2 * DFF; mode = pg8::EM_SWIGLU; ssq_in = SSl; o16 = BIG; break;
                        case 1: A = BIG; lda = DFF; Bt = WL + OW_1O; ldb = DFF; K = DFF; mode = pg8::EM_RES; scale = 0.5f; o16 = HB; ssq_out = SSl + MTOK; break;
                        case 2: A = HB; Bt = WL + OW_IN; N = NIN; mode = pg8::EM_QKV; ssq_in = SSl + MTOK; o16 = BIG; break;
                        case 3: mode = EM_ATTN; break;
                        case 4: case 6: case 8: A = HB; Bt = WL + OW_G + (size_t)((st - 4) >> 1) * DM * DM; mode = pg8::EM_GATE; ssq_in = SSl + MTOK; o16 = GS; sync = 0; break;
                        case 5: A = AO; Bt = WL + OW_BR; K = 256; ldb = 256; mode = pg8::EM_MERGE; flag = 0; o16 = M16; sync = 0; break;
                        case 7: A = AO + 256; Bt = WL + OW_BR + 262144; K = 256; ldb = 256; mode = pg8::EM_MERGE; flag = 1; o16 = M16; sync = 0; break;
                        case 9: A = AO + 512; Bt = WL + OW_BR + 524288; K = 512; ldb = 512; mode = pg8::EM_MERGE; flag = 2; o16 = M16; break;
                        case 10: A = M16; Bt = WL + OW_O; mode = pg8::EM_RES; scale = 1.0f; o16 = HB; ssq_out = SSl + 2 * MTOK; break;
                        case 11: A = HB; Bt = WL + OW_2I; N = 2 * DFF; mode = pg8::EM_SWIGLU; ssq_in = SSl + 2 * MTOK; o16 = BIG; break;
                        case 12: A = BIG; lda = DFF; Bt = WL + OW_2O; ldb = DFF; K = DFF; mode = pg8::EM_RES; scale = 0.5f; o16 = HB; ssq_out = SSl + 3 * MTOK; break;
                        case 13: A = PB; lda = PDIM; Bt = WL + OW_PP; ldb = PDIM; K = PDIM; mode = pg8::EM_STORE; o16 = GS; sync = 0; break;
                        default: A = HB; Bt = WL + OW_PG; mode = pg8::EM_PLE; ssq_in = SSl + 3 * MTOK; ssq_out = SSl + 4 * MTOK; o16 = AO; break;
                    }
                    d->A = A; d->Bt = Bt; d->ssq_in = ssq_in; d->ssq_out = ssq_out; d->o16 = o16;
                    d->gfox = qk_gain_fox + l * 128; d->gdiff = qk_gain_diff + l * 128; d->bfg = b_forget + l * 4; d->subln = diff_subln + l * 128; d->pl = pin + (size_t)l * MTOK * PDIM;
                    d->lda = lda; d->ldb = ldb; d->N = N; d->K = K; d->mode = mode; d->flag = flag; d->sync = sync; d->fin = (l == NLAYER - 1 && st == NSTEP - 1) ? 1 : 0;
                    d->hin = (st == 1) ? AO : HB;
                    d->scale = scale; d->lam = 0.f; d->oscale = 1.0f - lam_init; d->padf = 0.f;
                }
            }
        }
        for (int i = gt; i < 16 * MTOK; i += NGT) SS[MTOK + i] = 0.f;
        for (int i = gt; i < MTOK * 8; i += NGT) {
            const int m = i >> 3, f = i & 7; const float inv = powf(500000.0f, -(float)f * 0.125f);
            const float ang = (float)positions[m] * inv; cosT[i] = cosf(ang); sinT[i] = sinf(ang);
        }
        LAS float* scr = (LAS float*)(lds + wave * 16384);
        {
            constexpr int IT_WI = 16 * 176, IT_WO = 44 * 32, IT_IN = 16 * 104, IT_SQ = 16 * 32, IT_B4 = 4 * 32, IT_B8 = 8 * 32, IT_PP = 4 * 32;
            constexpr int IT_LAYER = 2 * IT_WI + 2 * IT_WO + IT_IN + 5 * IT_SQ + 2 * IT_B4 + IT_B8 + IT_PP;
#pragma unroll 1
            for (int gi = gw; gi < NLAYER * IT_LAYER; gi += NGW) {
                const int l = gi / IT_LAYER; int r = gi - l * IT_LAYER;
                bf16_t* WL = Wb + (size_t)l * LAYER_W_ELEMS;
                MatDesc d; d.gain = nullptr; d.ldw = DM; d.K = DM; d.Np = DM; d.kind = 0;
                if (r < IT_WI) { d.src = ffn1_wi + (size_t)l * DM * 2 * DFF; d.ldw = 2 * DFF; d.Np = 2 * DFF; d.kind = 1; d.gain = ffn1_norm + l * DM; d.dst = WL + OW_1I; }
                else if ((r -= IT_WI) < IT_WI) { d.src = ffn2_wi + (size_t)l * DM * 2 * DFF; d.ldw = 2 * DFF; d.Np = 2 * DFF; d.kind = 1; d.gain = ffn2_norm + l * DM; d.dst = WL + OW_2I; }
                else if ((r -= IT_WI) < IT_WO) { d.src = ffn1_wo + (size_t)l * DFF * DM; d.K = DFF; d.dst = WL + OW_1O; }
                else if ((r -= IT_WO) < IT_WO) { d.src = ffn2_wo + (size_t)l * DFF * DM; d.K = DFF; d.dst = WL + OW_2O; }
                else if ((r -= IT_WO) < IT_IN) { d.src = w_in + (size_t)l * DM * INCOLS; d.ldw = INCOLS; d.Np = NIN; d.kind = 2; d.gain = mix_norm + l * DM; d.dst = WL + OW_IN; }
                else if ((r -= IT_IN) < 3 * IT_SQ) { const int gidx = r / IT_SQ; r -= gidx * IT_SQ; d.src = w_in + (size_t)l * DM * INCOLS + 3076 + 1024 * gidx; d.ldw = INCOLS; d.gain = mix_norm + l * DM; d.dst = WL + OW_G + (size_t)gidx * DM * DM; }
                else if ((r -= 3 * IT_SQ) < IT_SQ) { d.src = w_o + (size_t)l * DM * DM; d.dst = WL + OW_O; }
                else if ((r -= IT_SQ) < IT_SQ) { d.src = ple_gate_w + (size_t)l * DM * DM; d.gain = ple_norm + l * DM; d.dst = WL + OW_PG; }
                else if ((r -= IT_SQ) < IT_B4) { d.src = w_br + (size_t)l * DM * DM; d.K = 256; d.dst = WL + OW_BR; }
                else if ((r -= IT_B4) < IT_B4) { d.src = w_br + (size_t)l * DM * DM + 256 * DM; d.K = 256; d.dst = WL + OW_BR + 262144; }
                else if ((r -= IT_B4) < IT_B8) { d.src = w_br + (size_t)l * DM * DM + 512 * DM; d.K = 512; d.dst = WL + OW_BR + 524288; }
                else { r -= IT_B8; d.src = ple_proj_w + (size_t)l * PDIM * DM; d.K = PDIM; d.dst = WL + OW_PP; }
                xpose_item(d, r, scr, lane);
            }
        }
        for (int m = gw; m < MTOK; m += NGW) {
            const f32x4* xr = (const f32x4*)(x + (size_t)m * DM) + lane;
            u32x2* hb = (u32x2*)(AO + (size_t)m * DM) + lane; u32x2* lb = (u32x2*)((bf16_t*)(ws + WS_LO) + (size_t)m * DM) + lane;
            float s2 = 0.f;
#pragma unroll
            for (int j = 0; j < 4; ++j) { const f32x4 v = xr[64 * j]; s2 += dot4(v); u32x2 w; w.x = cvtpk(v[0], v[1]); w.y = cvtpk(v[2], v[3]); hb[64 * j] = w;
                f32x4 g; g[0] = __uint_as_float(w.x << 16); g[1] = __uint_as_float(w.x & 0xffff0000u); g[2] = __uint_as_float(w.y << 16); g[3] = __uint_as_float(w.y & 0xffff0000u);
                u32x2 wl; wl.x = cvtpk(v[0] - g[0], v[1] - g[1]); wl.y = cvtpk(v[2] - g[2], v[3] - g[3]); lb[64 * j] = wl; }
            s2 = wave_sum(s2);
            if (lane == 0) SS[m] = s2;
        }
    }
    grid.sync();
    const unsigned xcc = xcd_barrier_post((unsigned*)(a.ws + WS_BAR), (volatile LAS unsigned*)(lds + att::LMISC + 128)).x;
#define GRID_BAR() xcd_barrier((unsigned*)(ws + WS_BAR), xcc, (volatile LAS unsigned*)(lds + att::LMISC + 128))

#pragma unroll 1
    for (int ls = 0; ls < NLAYER * NSTEP; ++ls) {
        unsigned char* ws = a.ws; asm volatile("" : "+s"(ws) :: "memory"); ws = (unsigned char*)(__attribute__((address_space(1))) unsigned char*)ws;
        float* out = a.out; asm volatile("" : "+s"(out)); out = (float*)(__attribute__((address_space(1))) float*)out;
        const Desc* dp = (const Desc*)(ws + WS_TAB) + ls;
        const int mode = uni_i(dp->mode);
        const int G = gridDim.x, bx = blockIdx.x;
        if (mode == EM_ATTN) {
            unsigned* ctl = (unsigned*)(ws + WS_CTL) + ls / NSTEP;
            const GAS bf16_t* QKVb = (const GAS bf16_t*)(ws + WS_BIG); GAS bf16_t* AOb = (GAS bf16_t*)(ws + WS_AO); const GAS float* logfB = (const GAS float*)(ws + WS_LOGF);
            const float lam = uni_f(((const float*)(ws + WS_CTL))[16 + ls / NSTEP]), oscale = uni_f(dp->oscale); const GAS float* subln = (const GAS float*)uni_ptr(dp->subln); const GAS float* gfoxp = (const GAS float*)uni_ptr(dp->gfox);
            LAS int* qslot = (LAS int*)(lds + att::LMISC);
            bool nomaxB, nomaxC;
            {
                const GAS float* gd = (const GAS float*)uni_ptr(dp->gdiff); const int ln = tid & 63;
                float a = fabsf(gfoxp[ln]), bq = fabsf(gfoxp[64 + ln]), c = fabsf(gd[ln]), d = fabsf(gd[64 + ln]);
#pragma unroll
                for (int o = 1; o < 64; o <<= 1) { a = fmaxf(a, __shfl_xor(a, o)); bq = fmaxf(bq, __shfl_xor(bq, o)); c = fmaxf(c, __shfl_xor(c, o)); d = fmaxf(d, __shfl_xor(d, o)); }
                nomaxB = __builtin_amdgcn_readfirstlane((64.0f * C2 * a * bq * 1.03f + 1.0f) <= 40.0f ? 1 : 0) != 0;
                nomaxC = __builtin_amdgcn_readfirstlane((64.0f * C2 * c * d * 1.03f + 1.0f) <= 40.0f ? 1 : 0) != 0;
            }
#ifndef ATT_REPS
#define ATT_REPS 1
#endif
            for (int rep = 0; rep < ATT_REPS; ++rep)
            for (;;) {
                if (tid == 0) qslot[0] = (int)atomicAdd(ctl + 4 * rep, 1u);
                __syncthreads();
                const int idx = qslot[0];
                __syncthreads();
                if (idx >= 1536) break;
                const int kind = idx >> 9, r = idx & 511, qb = 15 - (r >> 5), bh = r & 31, b = bh >> 2, hh = bh & 3;
                if (kind == 0) { if (nomaxC) att::attn_unit<2, true>(b, hh, qb, QKVb, AOb, logfB, subln, lam, oscale, lds); else att::attn_unit<2, false>(b, hh, qb, QKVb, AOb, logfB, subln, lam, oscale, lds); }
                else if (kind == 1) { if (nomaxB) att::attn_unit<1, true>(b, hh, qb, QKVb, AOb, logfB, gfoxp, 0.f, 1.f, lds); else att::attn_unit<1, false>(b, hh, qb, QKVb, AOb, logfB, gfoxp, 0.f, 1.f, lds); }
                else att::attn_unit<0>(b, hh, qb, QKVb, AOb, logfB, nullptr, 0.f, 1.f, lds);
            }
            GRID_BAR();
            continue;
        }
        if (ls % NSTEP == 11) {
            const float* pl = uni_ptr(dp->pl); bf16_t* PB = (bf16_t*)(ws + WS_PB);
            for (size_t i = (size_t)bx * 512 + tid; i < (size_t)MTOK * PDIM / 8; i += (size_t)G * 512) {
                const f32x4 v0 = *(const f32x4*)(pl + i * 8), v1 = *(const f32x4*)(pl + i * 8 + 4); *(u32x4*)(PB + i * 8) = pack8(v0, v1); }
        }
        pg8::Gemm g; pg8::Epi e;
        g.A = uni_ptr(dp->A); g.Bt = uni_ptr(dp->Bt); g.lda = uni_i(dp->lda); g.ldb = uni_i(dp->ldb); g.M = MTOK; g.N = uni_i(dp->N); g.K = uni_i(dp->K);
        e.mode = mode; e.flag = uni_i(dp->flag); e.scale = uni_f(dp->scale); e.ssq_in = (const GAS float*)uni_ptr(dp->ssq_in); e.ssq_out = (GAS float*)uni_ptr(dp->ssq_out); e.h = (GAS float*)out; e.o16 = (GAS bf16_t*)uni_ptr(dp->o16);
        e.mf = (GAS float*)(ws + WS_BIG); e.g16 = (const GAS bf16_t*)(ws + WS_GS);
        e.hin = (const GAS bf16_t*)uni_ptr(dp->hin); e.lo = (GAS bf16_t*)(ws + WS_LO); e.fin = uni_i(dp->fin);
        e.gfox = (const GAS float*)uni_ptr(dp->gfox); e.gdiff = (const GAS float*)uni_ptr(dp->gdiff); e.cosT = (const GAS float*)(ws + WS_COS); e.sinT = (const GAS float*)(ws + WS_SIN); e.bfg = (const GAS float*)uni_ptr(dp->bfg); e.logf = (GAS float*)(ws + WS_LOGF);
        const int do_sync = uni_i(dp->sync);
        pg8::StaticOrder S; S.init(g.M, g.N, G, bx);
        pg8::gemm_phase(lds, g, S, e);
#ifdef REP_MASK
        if ((REP_MASK >> (ls % NSTEP)) & 1) pg8::gemm_phase(lds, g, S, e);
#endif
        if (do_sync) GRID_BAR();
#ifdef SYNC_REPS
        if (do_sync) GRID_BAR();
#endif
    }
}

extern "C" void kernel_launch(void* const* d_in, const int* in_sizes, int n_in, void* d_out, int out_size, void* d_ws, size_t ws_size, hipStream_t stream) {
    static int grid = 0;
    if (grid == 0) {
        if (n_in != 21 || out_size != MTOK * DM || ws_size < WS_END) { fprintf(stderr, "kernel_launch: unexpected shapes: n_in %d out %d ws %zu (need %zu)\n", n_in, out_size, ws_size, (size_t)WS_END); grid = -1; return; }
        int dev = 0, cus = 0, per_cu = 0;
        hipGetDevice(&dev);
        hipDeviceGetAttribute(&cus, hipDeviceAttributeMultiprocessorCount, dev);
        hipFuncSetAttribute((const void*)fwd_megakernel, hipFuncAttributeMaxDynamicSharedMemorySize, LDS_BYTES);
        hipOccupancyMaxActiveBlocksPerMultiprocessor(&per_cu, (const void*)fwd_megakernel, 512, LDS_BYTES);
        if (per_cu < 1) { fprintf(stderr, "kernel_launch: occupancy query says %d blocks per CU\n", per_cu); per_cu = 1; }
        (void)hipGetLastError();
        grid = cus * per_cu;
    }
    if (grid < 0) return;
    Args a{};
    for (int i = 0; i < 21; ++i) a.in[i] = d_in[i];
    a.out = (float*)d_out; a.ws = (unsigned char*)d_ws;
    void* args[] = {&a};
    hipError_t e = hipLaunchCooperativeKernel((const void*)fwd_megakernel, dim3(grid), dim3(512), args, LDS_BYTES, stream);
    if (e != hipSuccess) fprintf(stderr, "cooperative launch failed: %s (grid %d)\n", hipGetErrorString(e), grid);
}
```

```cpp
#include <hip/hip_runtime.h>
#include <hip/hip_cooperative_groups.h>
#include <cstdio>
#include <cstdint>
namespace cg = cooperative_groups;

#define LAS __attribute__((address_space(3)))
#define GAS __attribute__((address_space(1)))
typedef unsigned short bf16_t;
typedef short bf16x8 __attribute__((ext_vector_type(8)));
typedef short s16x4 __attribute__((ext_vector_type(4)));
typedef float f32x4 __attribute__((ext_vector_type(4)));
typedef float f32x16 __attribute__((ext_vector_type(16)));
typedef unsigned u32x4 __attribute__((ext_vector_type(4)));
typedef unsigned u32x2 __attribute__((ext_vector_type(2)));
typedef float f32x2_t __attribute__((ext_vector_type(2)));
typedef __bf16 bf16x2_t __attribute__((ext_vector_type(2)));

constexpr int MTOK = 32768, DM = 1024, SEQ = 4096, NBATCH = 8, DFF = 2816, NLAYER = 4, PDIM = 256;
constexpr int INCOLS = 6148, NQKV = 3072, NIN = 3328;
constexpr float EPS = 1e-6f, L2E = 1.4426950408889634f, C2 = 0.125f * 1.4426950408889634f;

constexpr size_t MiB = 1u << 20;
constexpr size_t WS_CTL = 0;
constexpr size_t WS_SS = 1 * MiB;
constexpr size_t WS_COS = 4 * MiB, WS_SIN = 5 * MiB, WS_LOGF = 6 * MiB;
constexpr size_t WS_W = 8 * MiB;
constexpr size_t LAYER_W_ELEMS = 27262976;
constexpr size_t OW_1I = 0, OW_1O = 5767168, OW_IN = 8650752, OW_G = 12058624, OW_BR = 15204352, OW_O = 16252928, OW_2I = 17301504, OW_2O = 23068672, OW_PG = 25952256, OW_PP = 27000832;
constexpr size_t WS_HB = 216 * MiB;
constexpr size_t WS_BIG = 280 * MiB;
constexpr size_t WS_GS = 472 * MiB;
constexpr size_t WS_AO = 536 * MiB;
constexpr size_t WS_LO = 600 * MiB;
constexpr size_t WS_END = 664 * MiB;
constexpr size_t WS_PB = WS_BIG + 176 * MiB;

constexpr int LDS_BYTES = 147456;

__device__ __forceinline__ unsigned cvtpk(float lo, float hi) { f32x2_t v = {lo, hi}; bf16x2_t b = __builtin_convertvector(v, bf16x2_t); return __builtin_bit_cast(unsigned, b); }
__device__ __forceinline__ u32x4 pack8(f32x4 a, f32x4 b) { u32x4 w; w.x = cvtpk(a[0], a[1]); w.y = cvtpk(a[2], a[3]); w.z = cvtpk(b[0], b[1]); w.w = cvtpk(b[2], b[3]); return w; }
__device__ __forceinline__ void unpack8(u32x4 w, f32x4& a, f32x4& b) {
    a[0] = __uint_as_float(w.x << 16); a[1] = __uint_as_float(w.x & 0xffff0000u); a[2] = __uint_as_float(w.y << 16); a[3] = __uint_as_float(w.y & 0xffff0000u);
    b[0] = __uint_as_float(w.z << 16); b[1] = __uint_as_float(w.z & 0xffff0000u); b[2] = __uint_as_float(w.w << 16); b[3] = __uint_as_float(w.w & 0xffff0000u); }
__device__ __forceinline__ float fsigmoid(float x) { return __builtin_amdgcn_rcpf(1.0f + __builtin_amdgcn_exp2f(-x * L2E)); }
__device__ __forceinline__ f32x4 sig4(f32x4 x) { f32x4 r; r[0] = fsigmoid(x[0]); r[1] = fsigmoid(x[1]); r[2] = fsigmoid(x[2]); r[3] = fsigmoid(x[3]); return r; }
__device__ __forceinline__ float dot4(f32x4 a) { return (a[0] * a[0] + a[1] * a[1]) + (a[2] * a[2] + a[3] * a[3]); }

namespace pg8 {
constexpr int BM = 256, BK = 64, HALF = 128, HTB = HALF * BK * 2, STAGE_BYTES = 8 * HTB, NXCD = 8, WGM = 8;
__host__ __device__ __forceinline__ int lds_byte(int r, int c) { const int st = (r >> 4) * 2 + (c >> 5), rr = r & 15, cc = c & 31, ob = rr * 64 + cc * 2; return st * 1024 + (ob ^ (((ob >> 9) & 1) << 5)); }
__host__ __device__ __forceinline__ void stage_rc(int b, int& R, int& C) { const int st = b / 1024, sb = b % 1024, swz = sb ^ (((sb >> 9) & 1) << 5); R = (st >> 1) * 16 + swz / 64; C = (st & 1) * 32 + (swz % 64) / 2; }
__host__ __device__ __forceinline__ int perm32(int rho) { const int n = rho >> 4, i = rho & 15; return 8 * (i >> 2) + 4 * n + (i & 3); }

struct Unit { int pm, pn; };
struct Gemm { const bf16_t* A; const bf16_t* Bt; int lda, ldb, M, N, K; };

struct StaticOrder {
    int nM, nN, nwg, G, c;
    __host__ __device__ void init(int M, int N, int G_, int c_) { nM = M / BM; nN = N / BM; nwg = nM * nN; G = G_; c = c_; }
    __host__ __device__ bool next(int i, Unit& u) const {
        const long L = (long)i * G + c; if (L >= nwg) return false;
        int wgid = (int)L; { const int q = nwg / NXCD, r = nwg % NXCD, xcd = wgid % NXCD, off = wgid / NXCD; wgid = (xcd < r ? xcd * (q + 1) : r * (q + 1) + (xcd - r) * q) + off; }
        const int nig = WGM * nN, gid = wgid / nig, fm = gid * WGM, gsz = (nM - fm) < WGM ? (nM - fm) : WGM;
        u.pm = fm + ((wgid % nig) % gsz); u.pn = (wgid % nig) / gsz; return true;
    }
};

enum { EM_SWIGLU = 0, EM_RES = 1, EM_QKV = 2, EM_GATE = 3, EM_MERGE = 4, EM_STORE = 5, EM_PLE = 6 };
struct Epi {
    static constexpr bool PERM = true;
    int mode; int flag; float scale;
    const GAS float* ssq_in; GAS float* ssq_out; GAS float* h; GAS bf16_t* o16; GAS float* mf; const GAS bf16_t* g16;
    const GAS bf16_t* hin; GAS bf16_t* lo; int fin;
    const GAS float *gfox, *gdiff, *cosT, *sinT, *bfg; GAS float* logf;

    __device__ __forceinline__ void operator()(const f32x4 (&acc)[2][2][4][2], const Unit& u, int wr, int wc, int fr, int fq) const {
        const int rowb = u.pm * BM + wr * 64 + fr;
        if (mode == EM_SWIGLU) {
            const int colh = u.pn * 128 + wc * 32 + fq * 8;
            float rsv[2][4];
#pragma unroll
            for (int ai = 0; ai < 2; ++ai)
#pragma unroll
                for (int m = 0; m < 4; ++m) rsv[ai][m] = ssq_in[rowb + ai * HALF + m * 16];
#pragma unroll
            for (int ai = 0; ai < 2; ++ai)
#pragma unroll
                for (int m = 0; m < 4; ++m) {
                    const int row = rowb + ai * HALF + m * 16;
                    const float rstd = __builtin_amdgcn_rsqf(rsv[ai][m] * (1.0f / DM) + EPS);
                    f32x4 o[2];
#pragma unroll
                    for (int n = 0; n < 2; ++n) { const f32x4 a = acc[ai][0][m][n] * rstd, g = acc[ai][1][m][n] * rstd; o[n] = a * sig4(a) * g; }
                    *(GAS u32x4*)(o16 + (size_t)row * DFF + colh) = pack8(o[0], o[1]);
                }
        } else if (mode == EM_RES || mode == EM_PLE) {
#pragma unroll
            for (int ai = 0; ai < 2; ++ai)
#pragma unroll
                for (int m = 0; m < 4; ++m) {
                    const int row = rowb + ai * HALF + m * 16;
                    float rstd = 1.f; if (mode == EM_PLE) rstd = __builtin_amdgcn_rsqf(ssq_in[row] * (1.0f / DM) + EPS);
                    float ss = 0.f;
#pragma unroll
                    for (int bj = 0; bj < 2; ++bj) {
                        const size_t off = (size_t)row * DM + u.pn * BM + bj * HALF + wc * 32 + fq * 8;
                        f32x4 h0, h1, l0, l1; unpack8(*(const GAS u32x4*)(hin + off), h0, h1); unpack8(*(const GAS u32x4*)(lo + off), l0, l1);
                        h0 += l0; h1 += l1;
                        if (mode == EM_PLE) { f32x4 t0, t1; unpack8(*(const GAS u32x4*)(g16 + off), t0, t1);
                            h0 += sig4(acc[ai][bj][m][0] * rstd) * t0; h1 += sig4(acc[ai][bj][m][1] * rstd) * t1; }
                        else { h0 += acc[ai][bj][m][0] * scale; h1 += acc[ai][bj][m][1] * scale; }
                        if (fin) { *(GAS f32x4*)(h + off) = h0; *(GAS f32x4*)(h + off + 4) = h1; }
                        const u32x4 hw = pack8(h0, h1); f32x4 g0, g1; unpack8(hw, g0, g1);
                        *(GAS u32x4*)(o16 + off) = hw;
                        *(GAS u32x4*)(lo + off) = pack8(h0 - g0, h1 - g1);
                        ss += dot4(h0) + dot4(h1);
                    }
                    ss += __shfl_xor(ss, 16); ss += __shfl_xor(ss, 32);
                    if (fq == 0) (void)__hip_atomic_fetch_add(ssq_out + row, ss, __ATOMIC_RELAXED, __HIP_MEMORY_SCOPE_AGENT);
                }
        } else if (mode == EM_QKV) {
            const int T = u.pn;
            if (T == 12) {
                if (wc == 0 && fq == 0) {
                    const f32x4 bf = *(const GAS f32x4*)bfg;
#pragma unroll
                    for (int ai = 0; ai < 2; ++ai)
#pragma unroll
                        for (int m = 0; m < 4; ++m) {
                            const int row = rowb + ai * HALF + m * 16;
                            const float rstd = __builtin_amdgcn_rsqf(ssq_in[row] * (1.0f / DM) + EPS);
                            const f32x4 v = acc[ai][0][m][0] * rstd + bf; f32x4 o;
#pragma unroll
                            for (int i = 0; i < 4; ++i) o[i] = (fminf(v[i], 0.f) * L2E - __builtin_amdgcn_logf(1.0f + __builtin_amdgcn_exp2f(-fabsf(v[i]) * L2E)));
                            *(GAS f32x4*)(logf + (size_t)row * 4) = o;
                        }
                }
                return;
            }
            const bool do_norm = (T == 3 || T == 4 || (T >= 6 && T <= 9)), do_rope = (T >= 6 && T <= 9);
            const GAS float* gain = (T == 3) ? gfox : (T == 4) ? gfox + 64 : (T == 6 || T == 7) ? gdiff : gdiff + 64;
            const float sc = (T == 0 || T == 3 || T == 6 || T == 7) ? C2 : 1.0f;
            f32x4 gv[2][2];
#pragma unroll
            for (int bj = 0; bj < 2; ++bj)
#pragma unroll
                for (int n = 0; n < 2; ++n) gv[bj][n] = do_norm ? *(const GAS f32x4*)(gain + 32 * bj + 8 * fq + 4 * n) : (f32x4){1.f, 1.f, 1.f, 1.f};
#pragma unroll
            for (int ai = 0; ai < 2; ++ai)
#pragma unroll
                for (int m = 0; m < 4; ++m) {
                    const int row = rowb + ai * HALF + m * 16;
                    const float rstd = __builtin_amdgcn_rsqf(ssq_in[row] * (1.0f / DM) + EPS);
                    f32x4 x[2][2];
#pragma unroll
                    for (int bj = 0; bj < 2; ++bj)
#pragma unroll
                        for (int n = 0; n < 2; ++n) x[bj][n] = acc[ai][bj][m][n] * rstd;
                    if (do_norm) {
                        float ss = (dot4(x[0][0]) + dot4(x[0][1])) + (dot4(x[1][0]) + dot4(x[1][1]));
                        ss += __shfl_xor(ss, 16); ss += __shfl_xor(ss, 32);
                        const float rn = __builtin_amdgcn_rsqf(ss * (1.0f / 64.0f) + EPS);
#pragma unroll
                        for (int bj = 0; bj < 2; ++bj)
#pragma unroll
                            for (int n = 0; n < 2; ++n) x[bj][n] = x[bj][n] * rn * gv[bj][n];
                    }
                    if (do_rope) {
#pragma unroll
                        for (int n = 0; n < 2; ++n) {
                            f32x4 pr; pr[0] = __shfl_xor(x[0][n][0], 16); pr[1] = __shfl_xor(x[0][n][1], 16); pr[2] = __shfl_xor(x[0][n][2], 16); pr[3] = __shfl_xor(x[0][n][3], 16);
                            const f32x4 c = *(const GAS f32x4*)(cosT + (size_t)row * 8 + 4 * n), s = *(const GAS f32x4*)(sinT + (size_t)row * 8 + 4 * n);
                            if (fq == 0) x[0][n] = x[0][n] * c - pr * s; else if (fq == 1) x[0][n] = x[0][n] * c + pr * s;
                        }
                    }
#pragma unroll
                    for (int bj = 0; bj < 2; ++bj)
                        *(GAS u32x4*)(o16 + (size_t)row * NQKV + T * 256 + wc * 64 + bj * 32 + fq * 8) = pack8(x[bj][0] * sc, x[bj][1] * sc);
                }
        } else {
#pragma unroll
            for (int ai = 0; ai < 2; ++ai)
#pragma unroll
                for (int m = 0; m < 4; ++m) {
                    const int row = rowb + ai * HALF + m * 16;
                    float rstd = 1.f; if (mode == EM_GATE) rstd = __builtin_amdgcn_rsqf(ssq_in[row] * (1.0f / DM) + EPS);
#pragma unroll
                    for (int bj = 0; bj < 2; ++bj) {
                        const size_t off = (size_t)row * DM + u.pn * BM + bj * HALF + wc * 32 + fq * 8;
                        if (mode == EM_GATE) { *(GAS u32x4*)(o16 + off) = pack8(sig4(acc[ai][bj][m][0] * rstd), sig4(acc[ai][bj][m][1] * rstd)); }
                        else if (mode == EM_STORE) { *(GAS u32x4*)(o16 + off) = pack8(acc[ai][bj][m][0], acc[ai][bj][m][1]); }
                        else {
                            f32x4 g0, g1; unpack8(*(const GAS u32x4*)(g16 + off), g0, g1);
                            f32x4 v0 = g0 * acc[ai][bj][m][0], v1 = g1 * acc[ai][bj][m][1];
                            GAS bf16_t* mf16 = (GAS bf16_t*)mf;
                            if (flag > 0) { f32x4 a0, a1; unpack8(*(const GAS u32x4*)(mf16 + off), a0, a1); v0 += a0; v1 += a1; }
                            if (flag < 2) *(GAS u32x4*)(mf16 + off) = pack8(v0, v1);
                            else *(GAS u32x4*)(o16 + off) = pack8(v0, v1);
                        }
                    }
                }
        }
    }
};

__device__ __forceinline__ void gemm_phase(LAS unsigned char* lds, const Gemm g, const StaticOrder& S, const Epi& E) {
    int tid_ = threadIdx.x; asm volatile("" : "+v"(tid_));
    const int tid = tid_, wid = __builtin_amdgcn_readfirstlane(tid >> 6), lane = tid & 63, wr = wid >> 2, wc = wid & 3, fr = lane & 15, fq = lane >> 4;
    const int K = g.K, nt = K / BK;
    unsigned voffA[2], voffB[2];
#pragma unroll
    for (int i = 0; i < 2; ++i) { int R, C; stage_rc(tid * 16 + i * 8192, R, C); const int Rb = ((R & ~31) + perm32(R & 31));
        voffA[i] = (unsigned)(R * g.lda + C) * 2u; voffB[i] = (unsigned)(Rb * g.ldb + C) * 2u; }
    const size_t kstep = (size_t)(BK * 2);
    const size_t hstepA = (size_t)HALF * g.lda * 2, hstepB = (size_t)HALF * g.ldb * 2;
    const size_t tstepA = 2 * hstepA, tstepB = 2 * hstepB;
    const unsigned ldsw = (unsigned)wid * 1024u;
    const int aoff = lds_byte(wr * 64 + fr, fq * 8), boff = lds_byte(wc * 32 + fr, fq * 8);
#define PG8_SA(b, h) (((b) * 2 + (h)) * HTB)
#define PG8_SB(b, h) ((4 + (b) * 2 + (h)) * HTB)
#define PG8_STAGE(bufoff, gbase, voff) do { _Pragma("unroll") for (int _i = 0; _i < 2; ++_i) \
        __builtin_amdgcn_global_load_lds((const unsigned*)((const char*)(gbase) + (voff)[_i]), (LAS unsigned*)(lds + (bufoff) + ldsw + _i * 8192), 16, 0, 0); } while (0)
#define PG8_LDA(dst, b, h) do { _Pragma("unroll") for (int m = 0; m < 4; ++m) _Pragma("unroll") for (int k = 0; k < 2; ++k) dst[m][k] = *(const LAS bf16x8*)(lds + PG8_SA(b, h) + aoff + m * 2048 + k * 1024); } while (0)
#define PG8_LDB(dst, b, h) do { _Pragma("unroll") for (int n = 0; n < 2; ++n) _Pragma("unroll") for (int k = 0; k < 2; ++k) dst[n][k] = *(const LAS bf16x8*)(lds + PG8_SB(b, h) + boff + n * 2048 + k * 1024); } while (0)
#define PG8_MMA(ai, bj, At, Bt) do { __builtin_amdgcn_s_setprio(1); _Pragma("unroll") for (int m = 0; m < 4; ++m) _Pragma("unroll") for (int n = 0; n < 2; ++n) _Pragma("unroll") for (int k = 0; k < 2; ++k) \
        acc[ai][bj][m][n] = __builtin_amdgcn_mfma_f32_16x16x32_bf16(Bt[n][k], At[m][k], acc[ai][bj][m][n], 0, 0, 0); __builtin_amdgcn_s_setprio(0); } while (0)
#define PG8_WAIT_V(n) asm volatile("s_waitcnt vmcnt(" #n ")" ::: "memory")
#define PG8_WAIT_L(n) asm volatile("s_waitcnt lgkmcnt(" #n ")" ::: "memory")
#define PG8_BAR __builtin_amdgcn_s_barrier()
#define PG8_SCHED __builtin_amdgcn_sched_barrier(0)
    Unit cur, nxt; int ui = 0;
    if (!S.next(0, cur)) return;
    f32x4 acc[2][2][4][2];
#pragma unroll
    for (int a = 0; a < 2; ++a)
#pragma unroll
        for (int b = 0; b < 2; ++b)
#pragma unroll
            for (int m = 0; m < 4; ++m)
#pragma unroll
                for (int n = 0; n < 2; ++n) acc[a][b][m][n] = (f32x4){0.f, 0.f, 0.f, 0.f};
    bf16x8 At[4][2], B0[2][2], B1[2][2];
    const char* cA = (const char*)g.A + (size_t)cur.pm * tstepA; const char* cB = (const char*)g.Bt + (size_t)cur.pn * tstepB;
    PG8_STAGE(PG8_SB(0, 0), cB, voffB); PG8_STAGE(PG8_SB(0, 1), cB + hstepB, voffB); PG8_STAGE(PG8_SA(0, 0), cA, voffA); PG8_STAGE(PG8_SA(0, 1), cA + hstepA, voffA);
    if (wr == 1) PG8_BAR;
    PG8_WAIT_V(2); PG8_BAR;
    PG8_STAGE(PG8_SB(1, 0), cB + kstep, voffB); PG8_STAGE(PG8_SA(1, 0), cA + kstep, voffA); PG8_STAGE(PG8_SB(1, 1), cB + hstepB + kstep, voffB);
    PG8_WAIT_V(6); PG8_BAR;
    for (;;) {
        const bool has_next = S.next(ui + 1, nxt);
        const char* nA = has_next ? (const char*)g.A + (size_t)nxt.pm * tstepA : cA; const char* nB = has_next ? (const char*)g.Bt + (size_t)nxt.pn * tstepB : cB;
        for (int t = 0; t < nt; t += 2) {
            const bool last = (t == nt - 2);
            const char* a1 = cA + (size_t)(t + 1) * kstep;
            const char* a2 = last ? nA : cA + (size_t)(t + 2) * kstep; const char* b2 = last ? nB : cB + (size_t)(t + 2) * kstep;
            const char* a3 = a2 + kstep; const char* b3 = b2 + kstep;
            PG8_LDB(B0, 0, 0); PG8_LDB(B1, 0, 1); PG8_SCHED; PG8_LDA(At, 0, 0); PG8_STAGE(PG8_SA(1, 1), a1 + hstepA, voffA);
            PG8_WAIT_V(8); PG8_WAIT_L(0); PG8_BAR; PG8_MMA(0, 0, At, B0); PG8_MMA(0, 1, At, B1); PG8_BAR; PG8_SCHED;
            PG8_LDA(At, 0, 1); PG8_STAGE(PG8_SB(0, 0), b2, voffB); PG8_STAGE(PG8_SB(0, 1), b2 + hstepB, voffB); PG8_STAGE(PG8_SA(0, 0), a2, voffA);
            PG8_WAIT_V(8); PG8_WAIT_L(0); PG8_BAR; PG8_MMA(1, 0, At, B0); PG8_MMA(1, 1, At, B1); PG8_BAR; PG8_SCHED;
            PG8_LDB(B0, 1, 0); PG8_LDB(B1, 1, 1); PG8_SCHED; PG8_LDA(At, 1, 0); PG8_STAGE(PG8_SA(0, 1), a2 + hstepA, voffA);
            PG8_WAIT_V(8); PG8_WAIT_L(0); PG8_BAR; PG8_MMA(0, 0, At, B0); PG8_MMA(0, 1, At, B1); PG8_BAR; PG8_SCHED;
            PG8_LDA(At, 1, 1); PG8_STAGE(PG8_SB(1, 0), b3, voffB); PG8_STAGE(PG8_SB(1, 1), b3 + hstepB, voffB); PG8_STAGE(PG8_SA(1, 0), a3, voffA);
            PG8_WAIT_V(8); PG8_WAIT_L(0); PG8_BAR; PG8_MMA(1, 0, At, B0); PG8_MMA(1, 1, At, B1); PG8_BAR; PG8_SCHED;
        }
        if (wr == 0) PG8_BAR;
        E(acc, cur, wr, wc, fr, fq);
        if (!has_next) break;
#pragma unroll
        for (int a = 0; a < 2; ++a)
#pragma unroll
            for (int b = 0; b < 2; ++b)
#pragma unroll
                for (int m = 0; m < 4; ++m)
#pragma unroll
                    for (int n = 0; n < 2; ++n) acc[a][b][m][n] = (f32x4){0.f, 0.f, 0.f, 0.f};
        cur = nxt; cA = nA; cB = nB; ++ui;
        if (wr == 1) PG8_BAR;
    }
    PG8_WAIT_V(0);
    PG8_BAR;
#undef PG8_SA
#undef PG8_SB
#undef PG8_STAGE
#undef PG8_LDA
#undef PG8_LDB
#undef PG8_MMA
#undef PG8_WAIT_V
#undef PG8_WAIT_L
#undef PG8_BAR
#undef PG8_SCHED
}
}

namespace att {
constexpr int PITCH = NQKV, AOP = DM;
constexpr int LK = 0, LV = 16384, LWS = 65536, LOST = 67584, LCUM = LOST + 32768, LMISC = 133120;
__device__ __forceinline__ int crow(int r, int hi) { return (r & 3) + 8 * (r >> 2) + 4 * hi; }
__device__ __forceinline__ float partner32(float x, int hi) { auto rr = __builtin_amdgcn_permlane32_swap(__float_as_uint(x), __float_as_uint(x), false, false); return __uint_as_float(hi ? rr[0] : rr[1]); }
__device__ __forceinline__ float rowmax(const f32x16& p0, const f32x16& p1) {
    float a = fmaxf(fmaxf(p0[0], p0[1]), p1[0]), b = fmaxf(fmaxf(p0[2], p0[3]), p1[1]); a = fmaxf(fmaxf(a, p1[2]), p1[3]);
#pragma unroll
    for (int r = 4; r < 16; r += 4) { a = fmaxf(fmaxf(a, p0[r]), p0[r + 1]); b = fmaxf(fmaxf(b, p0[r + 2]), p0[r + 3]); a = fmaxf(fmaxf(a, p1[r]), p1[r + 1]); b = fmaxf(fmaxf(b, p1[r + 2]), p1[r + 3]); }
    const float m = fmaxf(a, b);
    auto rr = __builtin_amdgcn_permlane32_swap(__float_as_uint(m), __float_as_uint(m), false, false);
    return fmaxf(__uint_as_float(rr[0]), __uint_as_float(rr[1]));
}
__device__ __forceinline__ void qkt(f32x16& p0, f32x16& p1, const LAS char* kb, const bf16x8* qr, const f32x16& cinit) {
#pragma unroll
    for (int d0 = 0; d0 < 4; ++d0) {
        const bf16x8 b0 = *(const LAS bf16x8*)(kb + d0 * 2048);
        const bf16x8 b1 = *(const LAS bf16x8*)(kb + d0 * 2048 + 512);
        if (d0 == 0) { p0 = __builtin_amdgcn_mfma_f32_32x32x16_bf16(b0, qr[0], cinit, 0, 0, 0); p1 = __builtin_amdgcn_mfma_f32_32x32x16_bf16(b1, qr[0], cinit, 0, 0, 0); }
        else { p0 = __builtin_amdgcn_mfma_f32_32x32x16_bf16(b0, qr[d0], p0, 0, 0, 0); p1 = __builtin_amdgcn_mfma_f32_32x32x16_bf16(b1, qr[d0], p1, 0, 0, 0); }
    }
}
__device__ __forceinline__ void pv(f32x16* o, int vb, bf16x8 pa0, bf16x8 pa1, bf16x8 pa2, bf16x8 pa3) {
    s16x4 lo[2][4], hi[2][4];
#pragma unroll
    for (int d0 = 0; d0 < 2; ++d0)
#pragma unroll
        for (int ks = 0; ks < 4; ++ks) {
            asm volatile("ds_read_b64_tr_b16 %0,%1 offset:%c2" : "=&v"(lo[d0][ks]) : "v"(vb), "i"(d0 * 4096 + ks * 1024) : "memory");
            asm volatile("ds_read_b64_tr_b16 %0,%1 offset:%c2" : "=&v"(hi[d0][ks]) : "v"(vb), "i"(d0 * 4096 + ks * 1024 + 512) : "memory"); }
    asm volatile("s_waitcnt lgkmcnt(0)" ::: "memory"); __builtin_amdgcn_sched_barrier(0);
#define PK(d, k) (bf16x8){lo[d][k][0], lo[d][k][1], lo[d][k][2], lo[d][k][3], hi[d][k][0], hi[d][k][1], hi[d][k][2], hi[d][k][3]}
    o[0] = __builtin_amdgcn_mfma_f32_32x32x16_bf16(pa0, PK(0, 0), o[0], 0, 0, 0); o[1] = __builtin_amdgcn_mfma_f32_32x32x16_bf16(pa0, PK(1, 0), o[1], 0, 0, 0);
    o[0] = __builtin_amdgcn_mfma_f32_32x32x16_bf16(pa1, PK(0, 1), o[0], 0, 0, 0); o[1] = __builtin_amdgcn_mfma_f32_32x32x16_bf16(pa1, PK(1, 1), o[1], 0, 0, 0);
    o[0] = __builtin_amdgcn_mfma_f32_32x32x16_bf16(pa2, PK(0, 2), o[0], 0, 0, 0); o[1] = __builtin_amdgcn_mfma_f32_32x32x16_bf16(pa2, PK(1, 2), o[1], 0, 0, 0);
    o[0] = __builtin_amdgcn_mfma_f32_32x32x16_bf16(pa3, PK(0, 3), o[0], 0, 0, 0); o[1] = __builtin_amdgcn_mfma_f32_32x32x16_bf16(pa3, PK(1, 3), o[1], 0, 0, 0);
#undef PK
}

template <int MODE, bool NOMAX = false>
__device__ __forceinline__ void attn_unit(int b, int h, int qb, const GAS bf16_t* __restrict__ QKV, GAS bf16_t* __restrict__ AO, const GAS float* __restrict__ logf,
                                          const GAS float* __restrict__ subln, float lam, float oscale, LAS unsigned char* shm) {
    constexpr int DV = (MODE == 2) ? 128 : 64, NPASS = (MODE == 2) ? 2 : 1, ND = DV / 32;
    int tid_ = threadIdx.x; asm volatile("" : "+v"(tid_));
    const int tid = tid_, lane = tid & 63, r32 = lane & 31, hi = lane >> 5; const int wid = __builtin_amdgcn_readfirstlane(tid >> 6);
    const long rowbase = (long)b * SEQ; const int q0 = qb * 256;
    const int qcol = MODE == 0 ? h * 64 : MODE == 1 ? 768 + h * 64 : 1536 + h * 128;
    const int kcol = MODE == 0 ? 256 + h * 64 : MODE == 1 ? 1024 + h * 64 : 2048 + h * 128;
    const int vcol = MODE == 0 ? 512 + h * 64 : MODE == 1 ? 1280 + h * 64 : 2560 + h * 128;
    const int ocol = MODE == 0 ? h * 64 : MODE == 1 ? 256 + h * 64 : 512 + h * 128;
    const int NT = 4 * qb + 4, ktmax_w = 4 * qb + (wid >> 1);
    const unsigned lds0 = (unsigned)(uintptr_t)shm;
    LAS float* wsf = (LAS float*)(shm + LWS) + wid * 64;
    LAS float* cum = (LAS float*)(shm + LCUM);
    const int trel = 32 * (wid & 1) + r32;
    float cq = 0.f; int it0 = 0;
    if (MODE == 1) {
        const int n = q0 + 256, base = tid * 8; float v[8];
#pragma unroll
        for (int i = 0; i < 8; ++i) { const int s = base + i; v[i] = (s < n) ? logf[(size_t)(rowbase + s) * 4 + h] : 0.f; }
#pragma unroll
        for (int i = 1; i < 8; ++i) v[i] += v[i - 1];
        float inc = v[7];
#pragma unroll
        for (int o = 1; o < 64; o <<= 1) { const float t = __shfl_up(inc, o); if (lane >= o) inc += t; }
        LAS float* wt = (LAS float*)(shm + LMISC) + 16;
        if (lane == 63) wt[wid] = inc;
        __syncthreads();
        float woff = 0.f;
#pragma unroll
        for (int w = 0; w < 8; ++w) woff += (w < wid) ? wt[w] : 0.f;
        const float toff = woff + inc - v[7];
#pragma unroll
        for (int i = 0; i < 8; ++i) cum[base + i] = v[i] + toff;
        __syncthreads();
        cq = cum[q0 + wid * 32 + r32];
        float gq = fabsf(subln[lane]), gk = fabsf(subln[64 + lane]);
#pragma unroll
        for (int o = 1; o < 64; o <<= 1) { gq = fmaxf(gq, __shfl_xor(gq, o)); gk = fmaxf(gk, __shfl_xor(gk, o)); }
        const float Bb = 64.0f * C2 * gq * gk * 1.03f + 1.0f, thr = -(2.0f * Bb + 150.0f), c0 = cum[q0];
        while (it0 < NT - 4 && (c0 - cum[64 * it0 + 63]) < thr) ++it0;
        it0 = __builtin_amdgcn_readfirstlane(it0);
    }
    GAS bf16_t* Ow = AO + (size_t)(rowbase + q0 + wid * 32) * AOP + ocol;
    LAS bf16_t* stg = (LAS bf16_t*)(shm + LOST) + wid * (DV * 32);
#pragma unroll
    for (int pass = 0; pass < NPASS; ++pass) {
        const GAS bf16_t* Qw = QKV + (size_t)(rowbase + q0 + wid * 32) * PITCH + qcol + pass * 64;
        const GAS bf16_t* ksrc = QKV + (size_t)(rowbase + lane) * PITCH + kcol + pass * 64 + wid * 8;
        const GAS bf16_t* vsrc = QKV + (size_t)(rowbase + 16 * (wid & 3) + (lane >> 2)) * PITCH + vcol + (wid >> 2) * 32 + (lane & 3) * 8;
        bf16x8 qr[4];
#pragma unroll
        for (int d0 = 0; d0 < 4; ++d0) qr[d0] = *(const GAS bf16x8*)(Qw + (size_t)r32 * PITCH + d0 * 16 + hi * 8);
        float mhat = 0.f, l_reg = 0.f, carry = 0.f;
        f32x16 o[ND];
#pragma unroll
        for (int d = 0; d < ND; ++d) o[d] = f32x16{};
        u32x4 kreg, vreg0, vreg1 = u32x4{};
        { const int kt = (MODE == 0) ? NT - 1 : it0; const size_t go = (size_t)kt * 64 * PITCH;
          kreg = *(const GAS u32x4*)(ksrc + go); vreg0 = *(const GAS u32x4*)(vsrc + go); if (DV == 128) vreg1 = *(const GAS u32x4*)(vsrc + go + 64); }
        u32x4 pw0 = u32x4{}, pw1 = u32x4{}, pw2 = u32x4{}, pw3 = u32x4{};
        const bool lag = (wid >= 4); bool pend = false; int vs = 0, vsp = 0;
        const int vbl = (int)(lds0 + LV) + ((lane >> 4) & 1) * 32 + (lane & 3) * 8 + (4 * hi + ((lane & 15) >> 2)) * 64;
#define ATT_PV(VB_) do { pv(o, (VB_), __builtin_bit_cast(bf16x8, pw0), __builtin_bit_cast(bf16x8, pw1), __builtin_bit_cast(bf16x8, pw2), __builtin_bit_cast(bf16x8, pw3)); \
            if (DV == 128) pv(o + 2, (VB_) + 8192, __builtin_bit_cast(bf16x8, pw0), __builtin_bit_cast(bf16x8, pw1), __builtin_bit_cast(bf16x8, pw2), __builtin_bit_cast(bf16x8, pw3)); } while (0)
        {   *(LAS u32x4*)(shm + LK + (it0 & 1) * 8192 + wid * 1024 + lane * 16) = kreg;
            *(LAS u32x4*)(shm + LV + wid * 1024 + lane * 16) = vreg0;
            if (DV == 128) *(LAS u32x4*)(shm + LV + 8192 + wid * 1024 + lane * 16) = vreg1;
            const int kt1 = (MODE == 0) ? NT - 2 - it0 : it0 + 1; const size_t go = (size_t)kt1 * 64 * PITCH;
            kreg = *(const GAS u32x4*)(ksrc + go); vreg0 = *(const GAS u32x4*)(vsrc + go); if (DV == 128) vreg1 = *(const GAS u32x4*)(vsrc + go + 64); }
        for (int it = it0; it < NT; ++it) {
            const int kt = (MODE == 0) ? NT - 1 - it : it, slot = it & 1;
            const int vsn = (vs == 2) ? 0 : vs + 1;
            __syncthreads();
            if (it + 1 < NT) {
                *(LAS u32x4*)(shm + LK + (slot ^ 1) * 8192 + wid * 1024 + lane * 16) = kreg;
                *(LAS u32x4*)(shm + LV + vsn * 16384 + wid * 1024 + lane * 16) = vreg0;
                if (DV == 128) *(LAS u32x4*)(shm + LV + vsn * 16384 + 8192 + wid * 1024 + lane * 16) = vreg1; }
            if (it + 2 < NT) { const int ktn = (MODE == 0) ? kt - 2 : kt + 2; const size_t go = (size_t)ktn * 64 * PITCH;
                kreg = *(const GAS u32x4*)(ksrc + go); vreg0 = *(const GAS u32x4*)(vsrc + go); if (DV == 128) vreg1 = *(const GAS u32x4*)(vsrc + go + 64); }
            if (lag && pend) { ATT_PV(vbl + vsp * 16384); pend = false; }
            bool wdone = false;
            if (kt <= ktmax_w) {
                const LAS char* kb = (const LAS char*)(shm + LK + slot * 8192) + hi * 1024 + r32 * 16;
                const bool diag = (kt == ktmax_w);
                f32x16 p0, p1;
                if (MODE == 0) {
                    f32x16 cz = f32x16{}; asm volatile("" : "+v"(cz));
                    qkt(p0, p1, kb, qr, cz);
                    f32x16 L0, L1;
#pragma unroll
                    for (int r = 0; r < 16; ++r) {
                        const float z0 = p0[r], z1 = p1[r];
                        L0[r] = -__builtin_amdgcn_logf(1.0f + __builtin_amdgcn_exp2f(-z0)) - z0;
                        L1[r] = -__builtin_amdgcn_logf(1.0f + __builtin_amdgcn_exp2f(-z1)) - z1;
                    }
                    if (diag) {
#pragma unroll
                        for (int r = 0; r < 16; ++r) { const int kv = crow(r, hi);
                            if (kv >= trel) { L0[r] = 0.f; p0[r] = -INFINITY; }
                            if (kv + 32 >= trel) { L1[r] = 0.f; p1[r] = -INFINITY; } }
                    }
                    float T0[4], T1[4], PG0[4], PG1[4];
#pragma unroll
                    for (int g = 0; g < 4; ++g) {
                        const float g0 = (L0[4 * g] + L0[4 * g + 1]) + (L0[4 * g + 2] + L0[4 * g + 3]), g1 = (L1[4 * g] + L1[4 * g + 1]) + (L1[4 * g + 2] + L1[4 * g + 3]);
                        PG0[g] = partner32(g0, hi); PG1[g] = partner32(g1, hi); T0[g] = g0 + PG0[g]; T1[g] = g1 + PG1[g];
                    }
                    const float tot1 = (T1[0] + T1[1]) + (T1[2] + T1[3]), tot0 = (T0[0] + T0[1]) + (T0[2] + T0[3]);
                    float ST1[4], ST0[4];
                    ST1[3] = 0.f; ST1[2] = T1[3]; ST1[1] = ST1[2] + T1[2]; ST1[0] = ST1[1] + T1[1];
                    ST0[3] = tot1; ST0[2] = ST0[3] + T0[3]; ST0[1] = ST0[2] + T0[2]; ST0[0] = ST0[1] + T0[1];
#pragma unroll
                    for (int g = 0; g < 4; ++g) {
                        const float b0 = carry + ST0[g] + (hi == 0 ? PG0[g] : 0.f), b1 = carry + ST1[g] + (hi == 0 ? PG1[g] : 0.f);
                        L0[4 * g + 3] += b0; L0[4 * g + 2] += L0[4 * g + 3]; L0[4 * g + 1] += L0[4 * g + 2]; L0[4 * g] += L0[4 * g + 1];
                        L1[4 * g + 3] += b1; L1[4 * g + 2] += L1[4 * g + 3]; L1[4 * g + 1] += L1[4 * g + 2]; L1[4 * g] += L1[4 * g + 1];
                    }
#pragma unroll
                    for (int r = 0; r < 16; ++r) { p0[r] = __builtin_amdgcn_exp2f(p0[r] + L0[r]); p1[r] = __builtin_amdgcn_exp2f(p1[r] + L1[r]); }
                    carry += tot0 + tot1;
                    wdone = !__any(!(carry < -150.f));
                } else {
                    f32x16 negm;
                    { const float nm = NOMAX ? cq : cq - mhat;
#pragma unroll
                      for (int r = 0; r < 16; ++r) negm[r] = nm; }
                    asm volatile("" : "+v"(negm));
                    qkt(p0, p1, kb, qr, negm);
                    if (MODE == 1) {
#pragma unroll
                        for (int g = 0; g < 4; ++g) {
                            const f32x4 c0 = *(const LAS f32x4*)(cum + kt * 64 + 8 * g + 4 * hi), c1 = *(const LAS f32x4*)(cum + kt * 64 + 32 + 8 * g + 4 * hi);
#pragma unroll
                            for (int i = 0; i < 4; ++i) { p0[4 * g + i] -= c0[i]; p1[4 * g + i] -= c1[i]; }
                        }
                        if (diag) {
#pragma unroll
                            for (int r = 0; r < 16; ++r) { const int kv = crow(r, hi); if (kv > trel) p0[r] = -INFINITY; if (kv + 32 > trel) p1[r] = -INFINITY; }
                        }
                    }
                    const float rm = NOMAX ? 0.f : rowmax(p0, p1);
                    if (NOMAX) {
                    } else if (it == it0) {
                        mhat = rm;
#pragma unroll
                        for (int r = 0; r < 16; ++r) { p0[r] -= rm; p1[r] -= rm; }
                    } else if (__any(rm > 8.0f)) {
                        const float dl = fmaxf(rm, 0.f); mhat += dl;
#pragma unroll
                        for (int r = 0; r < 16; ++r) { p0[r] -= dl; p1[r] -= dl; }
                        const float f = __builtin_amdgcn_exp2f(-dl); l_reg *= f;
                        if (hi == 0) wsf[r32] = f;
                        asm volatile("s_waitcnt lgkmcnt(0)" ::: "memory");
#pragma unroll
                        for (int g = 0; g < 4; ++g) { const f32x4 fv = *(const LAS f32x4*)(wsf + 8 * g + 4 * hi);
#pragma unroll
                            for (int d = 0; d < ND; ++d)
#pragma unroll
                                for (int i = 0; i < 4; ++i) o[d][4 * g + i] *= fv[i]; }
                    }
                    float sacc = 0.f;
#pragma unroll
                    for (int r = 0; r < 16; ++r) { p0[r] = __builtin_amdgcn_exp2f(p0[r]); p1[r] = __builtin_amdgcn_exp2f(p1[r]); sacc += p0[r] + p1[r]; }
                    l_reg += sacc;
                }
                pw0 = (u32x4){cvtpk(p0[0], p0[1]), cvtpk(p0[2], p0[3]), cvtpk(p0[4], p0[5]), cvtpk(p0[6], p0[7])};
                pw1 = (u32x4){cvtpk(p0[8], p0[9]), cvtpk(p0[10], p0[11]), cvtpk(p0[12], p0[13]), cvtpk(p0[14], p0[15])};
                pw2 = (u32x4){cvtpk(p1[0], p1[1]), cvtpk(p1[2], p1[3]), cvtpk(p1[4], p1[5]), cvtpk(p1[6], p1[7])};
                pw3 = (u32x4){cvtpk(p1[8], p1[9]), cvtpk(p1[10], p1[11]), cvtpk(p1[12], p1[13]), cvtpk(p1[14], p1[15])};
                if (!lag) ATT_PV(vbl + vs * 16384); else pend = true;
            }
            vsp = vs; vs = vsn;
            if (MODE == 0) { if (__syncthreads_and(wdone ? 1 : 0)) break; }
        }
        if (lag && pend) ATT_PV(vbl + vsp * 16384);
#undef ATT_PV
        if (MODE != 0) {
            const float lt = l_reg + partner32(l_reg, hi);
            if (hi == 0) wsf[32 + r32] = lt;
            asm volatile("s_waitcnt lgkmcnt(0)" ::: "memory");
#pragma unroll
            for (int g = 0; g < 4; ++g) { const f32x4 lv = *(const LAS f32x4*)(wsf + 32 + 8 * g + 4 * hi);
#pragma unroll
                for (int i = 0; i < 4; ++i) { const float rl = __builtin_amdgcn_rcpf(lv[i]);
#pragma unroll
                    for (int d = 0; d < ND; ++d) o[d][4 * g + i] *= rl; } }
        }
        if (MODE == 2 && pass == 0) {
#pragma unroll
            for (int r = 0; r < 16; ++r) { const int orow = crow(r, hi);
#pragma unroll
                for (int d = 0; d < ND; ++d) stg[orow * DV + d * 32 + r32] = (bf16_t)(cvtpk(o[d][r], 0.f) & 0xffffu); }
        }
        if (MODE == 2 && pass == 1) {
            float ssr[16];
#pragma unroll
            for (int r = 0; r < 16; ++r) ssr[r] = 0.f;
#pragma unroll
            for (int r = 0; r < 16; ++r) { const int orow = crow(r, hi);
#pragma unroll
                for (int d = 0; d < ND; ++d) { const float a0 = __uint_as_float((unsigned)stg[orow * DV + d * 32 + r32] << 16);
                    o[d][r] = a0 - lam * o[d][r]; ssr[r] += o[d][r] * o[d][r]; } }
#pragma unroll
            for (int r = 0; r < 16; ++r) {
#pragma unroll
                for (int x = 1; x < 32; x <<= 1) ssr[r] += __shfl_xor(ssr[r], x);
                ssr[r] = __builtin_amdgcn_rsqf(ssr[r] * (1.0f / 128.0f) + EPS) * oscale;
            }
#pragma unroll
            for (int d = 0; d < ND; ++d) { const float gsl = subln[d * 32 + r32];
#pragma unroll
                for (int r = 0; r < 16; ++r) o[d][r] *= ssr[r] * gsl; }
        }
        if (MODE != 2 || pass == 1) {
#pragma unroll
            for (int r = 0; r < 16; ++r) { const int orow = crow(r, hi);
#pragma unroll
                for (int d = 0; d < ND; ++d) stg[orow * DV + d * 32 + r32] = (bf16_t)(cvtpk(o[d][r], 0.f) & 0xffffu); }
            asm volatile("s_waitcnt lgkmcnt(0)" ::: "memory");
            if (DV == 64) {
#pragma unroll
                for (int i = 0; i < 4; ++i) { const int row = i * 8 + (lane >> 3), ch = lane & 7; const u32x4 v = *(const LAS u32x4*)(stg + row * 64 + ch * 8); *(GAS u32x4*)(Ow + (size_t)row * AOP + ch * 8) = v; }
            } else {
#pragma unroll
                for (int i = 0; i < 8; ++i) { const int row = i * 4 + (lane >> 4), ch = lane & 15; const u32x4 v = *(const LAS u32x4*)(stg + row * 128 + ch * 8); *(GAS u32x4*)(Ow + (size_t)row * AOP + ch * 8) = v; }
            }
        }
        __syncthreads();
    }
}
}

__device__ __forceinline__ float wave_sum(float v) {
#pragma unroll
    for (int o = 1; o < 64; o <<= 1) v += __shfl_xor(v, o);
    return v;
}
struct MatDesc { const float* src; const float* gain; bf16_t* dst; int ldw, K, Np, kind; };
__device__ __forceinline__ void xpose_item(const MatDesc& d, int item, LAS float* scr, int lane) {
    const int nblk = d.Np / 32, kb = item / nblk, nb = item % nblk, k0 = 64 * kb, n0 = 32 * nb;
    int sc = n0, nvalid = 32;
    if (d.kind == 1) { const int tile = n0 >> 8, w = n0 & 255; sc = (w < 128) ? 128 * tile + w : DFF + 128 * tile + (w - 128); }
    else if (d.kind == 2) { const int T = n0 >> 8, w = n0 & 255;
        if (T == 12) { sc = 1536; nvalid = (w == 0) ? 4 : 0; }
        else { const int hh = (w >> 5) & 3, dd = 32 * (w >> 7), L = 256 * T + 64 * hh + dd; sc = (L < 1536) ? L : L + 4; } }
    {
        const int r8 = lane >> 3, q = lane & 7; const bool ok = (4 * q < nvalid);
        f32x4 v[8];
#pragma unroll
        for (int i = 0; i < 8; ++i) v[i] = ok ? *(const f32x4*)(d.src + (size_t)(k0 + 8 * i + r8) * d.ldw + sc + 4 * q) : (f32x4){0.f, 0.f, 0.f, 0.f};
#pragma unroll
        for (int i = 0; i < 8; ++i) { const int kk = 8 * i + r8; const float gm = d.gain ? d.gain[k0 + kk] : 1.f;
            LAS float* sp = scr + kk * 33 + 4 * q; sp[0] = v[i][0] * gm; sp[1] = v[i][1] * gm; sp[2] = v[i][2] * gm; sp[3] = v[i][3] * gm; }
    }
    asm volatile("s_waitcnt lgkmcnt(0)" ::: "memory");
    const int c = lane & 7;
#pragma unroll
    for (int jj = 0; jj < 4; ++jj) { const int n = (lane >> 3) + 8 * jj; const LAS float* s = scr + (8 * c) * 33 + n;
        u32x4 o; o.x = cvtpk(s[0 * 33], s[1 * 33]); o.y = cvtpk(s[2 * 33], s[3 * 33]); o.z = cvtpk(s[4 * 33], s[5 * 33]); o.w = cvtpk(s[6 * 33], s[7 * 33]);
        *(u32x4*)(d.dst + (size_t)(n0 + n) * d.K + k0 + 8 * c) = o; }
    asm volatile("s_waitcnt lgkmcnt(0)" ::: "memory");
}

#define XB_TMO      128
#define XB_XCNT(j)  (256  + 64 * (j))
#define XB_XSUB(j)  (1280 + 64 * (j))
#define XB_XGEN(j)  (2304 + 64 * (j))
#define XB_TOP      3328
#define XB_TOPGEN   3392
#define XCD_BAR_WORDS 3456
#define XB_SPIN_CAP (1u << 18)
__device__ __forceinline__ unsigned xb_ld(unsigned* p)              { return __hip_atomic_load(p, __ATOMIC_RELAXED, __HIP_MEMORY_SCOPE_AGENT); }
__device__ __forceinline__ unsigned xb_add(unsigned* p, unsigned v) { return __hip_atomic_fetch_add(p, v, __ATOMIC_RELAXED, __HIP_MEMORY_SCOPE_AGENT); }
__device__ __forceinline__ unsigned xb_xcc_id() { return (unsigned)__builtin_amdgcn_s_getreg((3 << 11) | 20) & 0xFu; }
#define XB_SPIN(cond, bar) do { unsigned _sp = 0; while (cond) { __builtin_amdgcn_s_sleep(1); \
    if ((++_sp & 255u) == 0u) { if (xb_ld(&(bar)[XB_TMO])) break; if (_sp > XB_SPIN_CAP) { atomicAdd(&(bar)[XB_TMO], 1u); break; } } } } while (0)
struct XcdBarrier { unsigned* bar; unsigned x; volatile LAS unsigned* st; };
__device__ __forceinline__ XcdBarrier xcd_barrier_post(unsigned* bar, volatile LAS unsigned* st) {
    XcdBarrier b; b.bar = bar; b.x = xb_xcc_id(); b.st = st;
    if (threadIdx.x == 0) (void)xb_add(&bar[XB_XCNT(b.x)], 1u);
    return b;
}
__device__ __forceinline__ void xcd_barrier_complete(unsigned* bar, unsigned x, unsigned& nloc, unsigned& nx) {
    const unsigned G = gridDim.x * gridDim.y * gridDim.z;
    unsigned sum, cnt, mine, sp = 0u;
    for (;;) {
        sum = 0u; cnt = 0u; mine = 0u;
#pragma unroll
        for (unsigned j = 0; j < 16; ++j) { const unsigned c = xb_ld(&bar[XB_XCNT(j)]); sum += c; cnt += (c > 0u) ? 1u : 0u; mine = (j == x) ? c : mine; }
        if (sum == G) break;
        __builtin_amdgcn_s_sleep(1);
        if ((++sp & 255u) == 0u) { if (xb_ld(&bar[XB_TMO])) break; if (sp > XB_SPIN_CAP) { atomicAdd(&bar[XB_TMO], 1u); break; } }
    }
    nloc = mine > 0u ? mine : 1u; nx = cnt > 0u ? cnt : 1u;
}
__device__ __forceinline__ void xcd_barrier(unsigned* bar, unsigned x, volatile LAS unsigned* st) {
    asm volatile("s_waitcnt vmcnt(0)" ::: "memory");
    __syncthreads();
    if (threadIdx.x == 0) {
        __builtin_amdgcn_s_waitcnt(0);
        unsigned nloc = st[0], nx = st[1];
        if (nloc == 0u) { xcd_barrier_complete(bar, x, nloc, nx); st[0] = nloc; st[1] = nx; }
        const unsigned old = xb_add(&bar[XB_XSUB(x)], 1u);
        const unsigned gen = old / nloc;
        if (old + 1u == (gen + 1u) * nloc) {
            __builtin_amdgcn_fence(__ATOMIC_RELEASE, "agent");
            asm volatile("s_waitcnt vmcnt(0)" ::: "memory");
            const unsigned og = xb_add(&bar[XB_TOP], 1u);
            const unsigned tg = og / nx;
            if (og + 1u == (tg + 1u) * nx) xb_add(&bar[XB_TOPGEN], 1u);
            else XB_SPIN(xb_ld(&bar[XB_TOPGEN]) == tg, bar);
            __builtin_amdgcn_fence(__ATOMIC_ACQUIRE, "agent");
            xb_add(&bar[XB_XGEN(x)], 1u);
            asm volatile("s_waitcnt vmcnt(0)" ::: "memory");
        } else {
            XB_SPIN(xb_ld(&bar[XB_XGEN(x)]) == gen, bar);
            __builtin_amdgcn_fence(__ATOMIC_ACQUIRE, "agent");
            asm volatile("s_waitcnt vmcnt(0)" ::: "memory");
        }
    }
    __syncthreads();
}
constexpr size_t WS_BAR = 65536;

struct Args { const void* in[21]; float* out; unsigned char* ws; };
struct Desc { const bf16_t* A; const bf16_t* Bt; const float* ssq_in; float* ssq_out; bf16_t* o16; const float* gfox; const float* gdiff; const float* bfg; const float* subln; const float* pl; const bf16_t* hin;
              int lda, ldb, N, K, mode, flag, sync, fin; float scale, lam, oscale, padf; };
template <class T> __device__ __forceinline__ T* uni_ptr(T* p) { const unsigned long long v = (unsigned long long)(uintptr_t)p;
    const unsigned lo = __builtin_amdgcn_readfirstlane((unsigned)v), hi = __builtin_amdgcn_readfirstlane((unsigned)(v >> 32));
    return (T*)(__attribute__((address_space(1))) T*)(uintptr_t)(((unsigned long long)hi << 32) | lo); }
__device__ __forceinline__ int uni_i(int v) { return __builtin_amdgcn_readfirstlane(v); }
__device__ __forceinline__ float uni_f(float v) { return __uint_as_float(__builtin_amdgcn_readfirstlane(__float_as_uint(v))); }
constexpr int EM_ATTN = 7, NSTEP = 15;
constexpr size_t WS_TAB = 4096;

__global__ void __launch_bounds__(512) fwd_megakernel(Args a) {
    extern __shared__ __attribute__((aligned(16))) unsigned char lds_raw[];
    LAS unsigned char* lds = (LAS unsigned char*)lds_raw;
    cg::grid_group grid = cg::this_grid();
    const int tid = threadIdx.x;

    {
        const int lane = tid & 63, wave = __builtin_amdgcn_readfirstlane(tid >> 6);
        const int G = gridDim.x, bx = blockIdx.x;
        unsigned char* ws = a.ws;
        const float* x = (const float*)a.in[0]; const float* pin = (const float*)a.in[1]; const int* positions = (const int*)a.in[2];
        const float* ffn1_norm = (const float*)a.in[3]; const float* ffn1_wi = (const float*)a.in[4]; const float* ffn1_wo = (const float*)a.in[5];
        const float* mix_norm = (const float*)a.in[6]; const float* w_in = (const float*)a.in[7]; const float* b_forget = (const float*)a.in[8];
        const float* qk_gain_fox = (const float*)a.in[9]; const float* qk_gain_diff = (const float*)a.in[10]; const float* diff_lambda = (const float*)a.in[11];
        const float* diff_subln = (const float*)a.in[12]; const float* w_br = (const float*)a.in[13]; const float* w_o = (const float*)a.in[14];
        const float* ffn2_norm = (const float*)a.in[15]; const float* ffn2_wi = (const float*)a.in[16]; const float* ffn2_wo = (const float*)a.in[17];
        const float* ple_norm = (const float*)a.in[18]; const float* ple_gate_w = (const float*)a.in[19]; const float* ple_proj_w = (const float*)a.in[20];
        float* out = a.out;
        unsigned* ctl = (unsigned*)(ws + WS_CTL);
        float* SS = (float*)(ws + WS_SS);
        float* cosT = (float*)(ws + WS_COS); float* sinT = (float*)(ws + WS_SIN);
        bf16_t* Wb = (bf16_t*)(ws + WS_W);
        bf16_t* HB = (bf16_t*)(ws + WS_HB); bf16_t* BIG = (bf16_t*)(ws + WS_BIG); bf16_t* GS = (bf16_t*)(ws + WS_GS); bf16_t* AO = (bf16_t*)(ws + WS_AO); bf16_t* PB = (bf16_t*)(ws + WS_PB);
        bf16_t* M16 = (bf16_t*)(ws + WS_BIG + 128 * MiB);
        const int gw = bx * 8 + wave, NGW = G * 8; const int gt = bx * 512 + tid, NGT = G * 512;
        if (gt < 16) ctl[gt] = 0u;
        if (gt < XCD_BAR_WORDS) ((unsigned*)(ws + WS_BAR))[gt] = 0u;
        if (tid < 2) ((volatile LAS unsigned*)(lds + att::LMISC + 128))[tid] = 0u;
        if (bx == 0 && wave >= 4) {
            const int l = wave - 4; const float* lf = diff_lambda + l * 256;
            const float s1 = wave_sum(lf[lane] * lf[64 + lane]), s2 = wave_sum(lf[128 + lane] * lf[192 + lane]);
            const float lam_init = 0.8f - 0.6f * expf(-0.3f * (float)l);
            if (lane == 0) ((float*)ctl)[16 + l] = expf(s1) - expf(s2) + lam_init;
        }
        if (bx == 0 && tid < NLAYER * NSTEP) {
            Desc* tab = (Desc*)(ws + WS_TAB);
            const int l = tid / NSTEP, st = tid % NSTEP;
            {
                const float lam_init = 0.8f - 0.6f * expf(-0.3f * (float)l);
                bf16_t* WL = Wb + (size_t)l * LAYER_W_ELEMS; float* SSl = SS + (size_t)(4 * l) * MTOK;
                {
                    Desc* d = tab + l * NSTEP + st;
                    const bf16_t* A = HB; const bf16_t* Bt = WL; const float* ssq_in = SSl; float* ssq_out = SSl; bf16_t* o16 = GS;
                    int lda = DM, ldb = DM, N = DM, K = DM, mode = 0, flag = 0, sync = 1; float scale = 1.f;
                    switch (st) {
                        case 0: A = AO; Bt = WL + OW_1I; N = 2 * DFF; mode = pg8::EM_SWIGLU; ssq_in = SSl; o16 = BIG; break;
                        case 1: A = BIG; lda = DFF; Bt = WL + OW_1O; ldb = DFF; K = DFF; mode = pg8::EM_RES; scale = 0.5f; o16 = HB; ssq_out = SSl + MTOK; break;
                        case 2: A = HB; Bt = WL + OW_IN; N = NIN; mode = pg8::EM_QKV; ssq_in = SSl + MTOK; o16 = BIG; break;
                        case 3: mode = EM_ATTN; break;
                        case 4: case 6: case 8: A = HB; Bt = WL + OW_G + (size_t)((st - 4) >> 1) * DM * DM; mode = pg8::EM_GATE; ssq_in = SSl + MTOK; o16 = GS; sync = 0; break;
                        case 5: A = AO; Bt = WL + OW_BR; K = 256; ldb = 256; mode = pg8::EM_MERGE; flag = 0; o16 = M16; sync = 0; break;
                        case 7: A = AO + 256; Bt = WL + OW_BR + 262144; K = 256; ldb = 256; mode = pg8::EM_MERGE; flag = 1; o16 = M16; sync = 0; break;
                        case 9: A = AO + 512; Bt = WL + OW_BR + 524288; K = 512; ldb = 512; mode = pg8::EM_MERGE; flag = 2; o16 = M16; break;
                        case 10: A = M16; Bt = WL + OW_O; mode = pg8::EM_RES; scale = 1.0f; o16 = HB; ssq_out = SSl + 2 * MTOK; break;
                        case 11: A = HB; Bt = WL + OW_2I; N = 2 * DFF; mode = pg8::EM_SWIGLU; ssq_in = SSl + 2 * MTOK; o16 = BIG; break;
                        case 12: A = BIG; lda = DFF; Bt = WL + OW_2O; ldb = DFF; K = DFF; mode = pg8::EM_RES; scale = 0.5f; o16 = HB; ssq_out = SSl + 3 * MTOK; break;
                        case 13: A = PB; lda = PDIM; Bt = WL + OW_PP; ldb = PDIM; K = PDIM; mode = pg8::EM_STORE; o16 = GS; sync = 0; break;
                        default: A = HB; Bt = WL + OW_PG; mode = pg8::EM_PLE; ssq_in = SSl + 3 * MTOK; ssq_out = SSl + 4 * MTOK; o16 = AO; break;
                    }
                    d->A = A; d->Bt = Bt; d->ssq_in = ssq_in; d->ssq_out = ssq_out; d->o16 = o16;
                    d->gfox = qk_gain_fox + l * 128; d->gdiff = qk_gain_diff + l * 128; d->bfg = b_forget + l * 4; d->subln = diff_subln + l * 128; d->pl = pin + (size_t)l * MTOK * PDIM;
                    d->lda = lda; d->ldb = ldb; d->N = N; d->K = K; d->mode = mode; d->flag = flag; d->sync = sync; d->fin = (l == NLAYER - 1 && st == NSTEP - 1) ? 1 : 0;
                    d->hin = (st == 1) ? AO : HB;
                    d->scale = scale; d->lam = 0.f; d->oscale = 1.0f - lam_init; d->padf = 0.f;
                }
            }
        }
        for (int i = gt; i < 16 * MTOK; i += NGT) SS[MTOK + i] = 0.f;
        for (int i = gt; i < MTOK * 8; i += NGT) {
            const int m = i >> 3, f = i & 7; const float inv = powf(500000.0f, -(float)f * 0.125f);
            const float ang = (float)positions[m] * inv; cosT[i] = cosf(ang); sinT[i] = sinf(ang);
        }
        LAS float* scr = (LAS float*)(lds + wave * 16384);
        {
            constexpr int IT_WI = 16 * 176, IT_WO = 44 * 32, IT_IN = 16 * 104, IT_SQ = 16 * 32, IT_B4 = 4 * 32, IT_B8 = 8 * 32, IT_PP = 4 * 32;
            constexpr int IT_LAYER = 2 * IT_WI + 2 * IT_WO + IT_IN + 5 * IT_SQ + 2 * IT_B4 + IT_B8 + IT_PP;
#pragma unroll 1
            for (int gi = gw; gi < NLAYER * IT_LAYER; gi += NGW) {
                const int l = gi / IT_LAYER; int r = gi - l * IT_LAYER;
                bf16_t* WL = Wb + (size_t)l * LAYER_W_ELEMS;
                MatDesc d; d.gain = nullptr; d.ldw = DM; d.K = DM; d.Np = DM; d.kind = 0;
                if (r < IT_WI) { d.src = ffn1_wi + (size_t)l * DM * 2 * DFF; d.ldw = 2 * DFF; d.Np = 2 * DFF; d.kind = 1; d.gain = ffn1_norm + l * DM; d.dst = WL + OW_1I; }
                else if ((r -= IT_WI) < IT_WI) { d.src = ffn2_wi + (size_t)l * DM * 2 * DFF; d.ldw = 2 * DFF; d.Np = 2 * DFF; d.kind = 1; d.gain = ffn2_norm + l * DM; d.dst = WL + OW_2I; }
                else if ((r -= IT_WI) < IT_WO) { d.src = ffn1_wo + (size_t)l * DFF * DM; d.K = DFF; d.dst = WL + OW_1O; }
                else if ((r -= IT_WO) < IT_WO) { d.src = ffn2_wo + (size_t)l * DFF * DM; d.K = DFF; d.dst = WL + OW_2O; }
                else if ((r -= IT_WO) < IT_IN) { d.src = w_in + (size_t)l * DM * INCOLS; d.ldw = INCOLS; d.Np = NIN; d.kind = 2; d.gain = mix_norm + l * DM; d.dst = WL + OW_IN; }
                else if ((r -= IT_IN) < 3 * IT_SQ) { const int gidx = r / IT_SQ; r -= gidx * IT_SQ; d.src = w_in + (size_t)l * DM * INCOLS + 3076 + 1024 * gidx; d.ldw = INCOLS; d.gain = mix_norm + l * DM; d.dst = WL + OW_G + (size_t)gidx * DM * DM; }
                else if ((r -= 3 * IT_SQ) < IT_SQ) { d.src = w_o + (size_t)l * DM * DM; d.dst = WL + OW_O; }
                else if ((r -= IT_SQ) < IT_SQ) { d.src = ple_gate_w + (size_t)l * DM * DM; d.gain = ple_norm + l * DM; d.dst = WL + OW_PG; }
                else if ((r -= IT_SQ) < IT_B4) { d.src = w_br + (size_t)l * DM * DM; d.K = 256; d.dst = WL + OW_BR; }
                else if ((r -= IT_B4) < IT_B4) { d.src = w_br + (size_t)l * DM * DM + 256 * DM; d.K = 256; d.dst = WL + OW_BR + 262144; }
                else if ((r -= IT_B4) < IT_B8) { d.src = w_br + (size_t)l * DM * DM + 512 * DM; d.K = 512; d.dst = WL + OW_BR + 524288; }
                else { r -= IT_B8; d.src = ple_proj_w + (size_t)l * PDIM * DM; d.K = PDIM; d.dst = WL + OW_PP; }
                xpose_item(d, r, scr, lane);
            }
        }
        for (int m = gw; m < MTOK; m += NGW) {
            const f32x4* xr = (const f32x4*)(x + (size_t)m * DM) + lane;
            u32x2* hb = (u32x2*)(AO + (size_t)m * DM) + lane; u32x2* lb = (u32x2*)((bf16_t*)(ws + WS_LO) + (size_t)m * DM) + lane;
            float s2 = 0.f;
#pragma unroll
            for (int j = 0; j < 4; ++j) { const f32x4 v = xr[64 * j]; s2 += dot4(v); u32x2 w; w.x = cvtpk(v[0], v[1]); w.y = cvtpk(v[2], v[3]); hb[64 * j] = w;
                f32x4 g; g[0] = __uint_as_float(w.x << 16); g[1] = __uint_as_float(w.x & 0xffff0000u); g[2] = __uint_as_float(w.y << 16); g[3] = __uint_as_float(w.y & 0xffff0000u);
                u32x2 wl; wl.x = cvtpk(v[0] - g[0], v[1] - g[1]); wl.y = cvtpk(v[2] - g[2], v[3] - g[3]); lb[64 * j] = wl; }
            s2 = wave_sum(s2);
            if (lane == 0) SS[m] = s2;
        }
    }
    grid.sync();
    const unsigned xcc = xcd_barrier_post((unsigned*)(a.ws + WS_BAR), (volatile LAS unsigned*)(lds + att::LMISC + 128)).x;
#define GRID_BAR() xcd_barrier((unsigned*)(ws + WS_BAR), xcc, (volatile LAS unsigned*)(lds + att::LMISC + 128))

#pragma unroll 1
    for (int ls = 0; ls < NLAYER * NSTEP; ++ls) {
        unsigned char* ws = a.ws; asm volatile("" : "+s"(ws) :: "memory"); ws = (unsigned char*)(__attribute__((address_space(1))) unsigned char*)ws;
        float* out = a.out; asm volatile("" : "+s"(out)); out = (float*)(__attribute__((address_space(1))) float*)out;
        const Desc* dp = (const Desc*)(ws + WS_TAB) + ls;
        const int mode = uni_i(dp->mode);
        const int G = gridDim.x, bx = blockIdx.x;
        if (mode == EM_ATTN) {
            unsigned* ctl = (unsigned*)(ws + WS_CTL) + ls / NSTEP;
            const GAS bf16_t* QKVb = (const GAS bf16_t*)(ws + WS_BIG); GAS bf16_t* AOb = (GAS bf16_t*)(ws + WS_AO); const GAS float* logfB = (const GAS float*)(ws + WS_LOGF);
            const float lam = uni_f(((const float*)(ws + WS_CTL))[16 + ls / NSTEP]), oscale = uni_f(dp->oscale); const GAS float* subln = (const GAS float*)uni_ptr(dp->subln); const GAS float* gfoxp = (const GAS float*)uni_ptr(dp->gfox);
            LAS int* qslot = (LAS int*)(lds + att::LMISC);
            bool nomaxB, nomaxC;
            {
                const GAS float* gd = (const GAS float*)uni_ptr(dp->gdiff); const int ln = tid & 63;
                float a = fabsf(gfoxp[ln]), bq = fabsf(gfoxp[64 + ln]), c = fabsf(gd[ln]), d = fabsf(gd[64 + ln]);
#pragma unroll
                for (int o = 1; o < 64; o <<= 1) { a = fmaxf(a, __shfl_xor(a, o)); bq = fmaxf(bq, __shfl_xor(bq, o)); c = fmaxf(c, __shfl_xor(c, o)); d = fmaxf(d, __shfl_xor(d, o)); }
                nomaxB = __builtin_amdgcn_readfirstlane((64.0f * C2 * a * bq * 1.03f + 1.0f) <= 40.0f ? 1 : 0) != 0;
                nomaxC = __builtin_amdgcn_readfirstlane((64.0f * C2 * c * d * 1.03f + 1.0f) <= 40.0f ? 1 : 0) != 0;
            }
#ifndef ATT_REPS
#define ATT_REPS 1
#endif
            for (int rep = 0; rep < ATT_REPS; ++rep)
            for (;;) {
                if (tid == 0) qslot[0] = (int)atomicAdd(ctl + 4 * rep, 1u);
                __syncthreads();
                const int idx = qslot[0];
                __syncthreads();
                if (idx >= 1536) break;
                const int kind = idx >> 9, r = idx & 511, qb = 15 - (r >> 5), bh = r & 31, b = bh >> 2, hh = bh & 3;
                if (kind == 0) { if (nomaxC) att::attn_unit<2, true>(b, hh, qb, QKVb, AOb, logfB, subln, lam, oscale, lds); else att::attn_unit<2, false>(b, hh, qb, QKVb, AOb, logfB, subln, lam, oscale, lds); }
                else if (kind == 1) { if (nomaxB) att::attn_unit<1, true>(b, hh, qb, QKVb, AOb, logfB, gfoxp, 0.f, 1.f, lds); else att::attn_unit<1, false>(b, hh, qb, QKVb, AOb, logfB, gfoxp, 0.f, 1.f, lds); }
                else att::attn_unit<0>(b, hh, qb, QKVb, AOb, logfB, nullptr, 0.f, 1.f, lds);
            }
            GRID_BAR();
            continue;
        }
        if (ls % NSTEP == 11) {
            const float* pl = uni_ptr(dp->pl); bf16_t* PB = (bf16_t*)(ws + WS_PB);
            for (size_t i = (size_t)bx * 512 + tid; i < (size_t)MTOK * PDIM / 8; i += (size_t)G * 512) {
                const f32x4 v0 = *(const f32x4*)(pl + i * 8), v1 = *(const f32x4*)(pl + i * 8 + 4); *(u32x4*)(PB + i * 8) = pack8(v0, v1); }
        }
        pg8::Gemm g; pg8::Epi e;
        g.A = uni_ptr(dp->A); g.Bt = uni_ptr(dp->Bt); g.lda = uni_i(dp->lda); g.ldb = uni_i(dp->ldb); g.M = MTOK; g.N = uni_i(dp->N); g.K = uni_i(dp->K);
        e.mode = mode; e.flag = uni_i(dp->flag); e.scale = uni_f(dp->scale); e.ssq_in = (const GAS float*)uni_ptr(dp->ssq_in); e.ssq_out = (GAS float*)uni_ptr(dp->ssq_out); e.h = (GAS float*)out; e.o16 = (GAS bf16_t*)uni_ptr(dp->o16);
        e.mf = (GAS float*)(ws + WS_BIG); e.g16 = (const GAS bf16_t*)(ws + WS_GS);
        e.hin = (const GAS bf16_t*)uni_ptr(dp->hin); e.lo = (GAS bf16_t*)(ws + WS_LO); e.fin = uni_i(dp->fin);
        e.gfox = (const GAS float*)uni_ptr(dp->gfox); e.gdiff = (const GAS float*)uni_ptr(dp->gdiff); e.cosT = (const GAS float*)(ws + WS_COS); e.sinT = (const GAS float*)(ws + WS_SIN); e.bfg = (const GAS float*)uni_ptr(dp->bfg); e.logf = (GAS float*)(ws + WS_LOGF);
        const int do_sync = uni_i(dp->sync);
        pg8::StaticOrder S; S.init(g.M, g.N, G, bx);
        pg8::gemm_phase(lds, g, S, e);
#ifdef REP_MASK
        if ((REP_MASK >> (ls % NSTEP)) & 1) pg8::gemm_phase(lds, g, S, e);
#endif
        if (do_sync) GRID_BAR();
#ifdef SYNC_REPS
        if (do_sync) GRID_BAR();
#endif
    }
}

extern "C" void kernel_launch(void* const* d_in, const int* in_sizes, int n_in, void* d_out, int out_size, void* d_ws, size_t ws_size, hipStream_t stream) {
    static int grid = 0;
    if (grid == 0) {
        if (n_in != 21 || out_size != MTOK * DM || ws_size < WS_END) { fprintf(stderr, "kernel_launch: unexpected shapes: n_in %d out %d ws %zu (need %zu)\n", n_in, out_size, ws_size, (size_t)WS_END); grid = -1; return; }
        int dev = 0, cus = 0, per_cu = 0;
        hipGetDevice(&dev);
        hipDeviceGetAttribute(&cus, hipDeviceAttributeMultiprocessorCount, dev);
        hipFuncSetAttribute((const void*)fwd_megakernel, hipFuncAttributeMaxDynamicSharedMemorySize, LDS_BYTES);
        hipOccupancyMaxActiveBlocksPerMultiprocessor(&per_cu, (const void*)fwd_megakernel, 512, LDS_BYTES);
        if (per_cu < 1) { fprintf(stderr, "kernel_launch: occupancy query says %d blocks per CU\n", per_cu); per_cu = 1; }
        (void)hipGetLastError();
        grid = cus * per_cu;
    }
    if (grid < 0) return;
    Args a{};
    for (int i = 0; i < 21; ++i) a.in[i] = d_in[i];
    a.out = (float*)d_out; a.ws = (unsigned char*)d_ws;
    void* args[] = {&a};
    hipError_t e = hipLaunchCooperativeKernel((const void*)fwd_megakernel, dim3(grid), dim3(512), args, LDS_BYTES, stream);
    if (e != hipSuccess) fprintf(stderr, "cooperative launch failed: %s (grid %d)\n", hipGetErrorString(e), grid);
}
```

```cpp
#include <hip/hip_runtime.h>
#include <hip/hip_cooperative_groups.h>
#include <cstdio>
#include <cstdint>
namespace cg = cooperative_groups;

#define LAS __attribute__((address_space(3)))
#define GAS __attribute__((address_space(1)))
typedef unsigned short bf16_t;
typedef short bf16x8 __attribute__((ext_vector_type(8)));
typedef short s16x4 __attribute__((ext_vector_type(4)));
typedef float f32x4 __attribute__((ext_vector_type(4)));
typedef float f32x16 __attribute__((ext_vector_type(16)));
typedef unsigned u32x4 __attribute__((ext_vector_type(4)));
typedef unsigned u32x2 __attribute__((ext_vector_type(2)));
typedef float f32x2_t __attribute__((ext_vector_type(2)));
typedef __bf16 bf16x2_t __attribute__((ext_vector_type(2)));

constexpr int MTOK = 32768, DM = 1024, SEQ = 4096, NBATCH = 8, DFF = 2816, NLAYER = 4, PDIM = 256;
constexpr int INCOLS = 6148, NQKV = 3072, NIN = 3328;
constexpr float EPS = 1e-6f, L2E = 1.4426950408889634f, C2 = 0.125f * 1.4426950408889634f;

constexpr size_t MiB = 1u << 20;
constexpr size_t WS_CTL = 0;
constexpr size_t WS_SS = 1 * MiB;
constexpr size_t WS_COS = 4 * MiB, WS_SIN = 5 * MiB, WS_LOGF = 6 * MiB;
constexpr size_t WS_W = 8 * MiB;
constexpr size_t LAYER_W_ELEMS = 27262976;
constexpr size_t OW_1I = 0, OW_1O = 5767168, OW_IN = 8650752, OW_G = 12058624, OW_BR = 15204352, OW_O = 16252928, OW_2I = 17301504, OW_2O = 23068672, OW_PG = 25952256, OW_PP = 27000832;
constexpr size_t WS_HB = 216 * MiB;
constexpr size_t WS_BIG = 280 * MiB;
constexpr size_t WS_GS = 472 * MiB;
constexpr size_t WS_AO = 536 * MiB;
constexpr size_t WS_LO = 600 * MiB;
constexpr size_t WS_END = 664 * MiB;
constexpr size_t WS_PB = WS_BIG + 176 * MiB;

constexpr int LDS_BYTES = 147456;

__device__ __forceinline__ unsigned cvtpk(float lo, float hi) { f32x2_t v = {lo, hi}; bf16x2_t b = __builtin_convertvector(v, bf16x2_t); return __builtin_bit_cast(unsigned, b); }
__device__ __forceinline__ u32x4 pack8(f32x4 a, f32x4 b) { u32x4 w; w.x = cvtpk(a[0], a[1]); w.y = cvtpk(a[2], a[3]); w.z = cvtpk(b[0], b[1]); w.w = cvtpk(b[2], b[3]); return w; }
__device__ __forceinline__ void unpack8(u32x4 w, f32x4& a, f32x4& b) {
    a[0] = __uint_as_float(w.x << 16); a[1] = __uint_as_float(w.x & 0xffff0000u); a[2] = __uint_as_float(w.y << 16); a[3] = __uint_as_float(w.y & 0xffff0000u);
    b[0] = __uint_as_float(w.z << 16); b[1] = __uint_as_float(w.z & 0xffff0000u); b[2] = __uint_as_float(w.w << 16); b[3] = __uint_as_float(w.w & 0xffff0000u); }
__device__ __forceinline__ float fsigmoid(float x) { return __builtin_amdgcn_rcpf(1.0f + __builtin_amdgcn_exp2f(-x * L2E)); }
__device__ __forceinline__ f32x4 sig4(f32x4 x) { f32x4 r; r[0] = fsigmoid(x[0]); r[1] = fsigmoid(x[1]); r[2] = fsigmoid(x[2]); r[3] = fsigmoid(x[3]); return r; }
__device__ __forceinline__ float dot4(f32x4 a) { return (a[0] * a[0] + a[1] * a[1]) + (a[2] * a[2] + a[3] * a[3]); }

namespace pg8 {
constexpr int BM = 256, BK = 64, HALF = 128, HTB = HALF * BK * 2, STAGE_BYTES = 8 * HTB, NXCD = 8, WGM = 8;
__host__ __device__ __forceinline__ int lds_byte(int r, int c) { const int st = (r >> 4) * 2 + (c >> 5), rr = r & 15, cc = c & 31, ob = rr * 64 + cc * 2; return st * 1024 + (ob ^ (((ob >> 9) & 1) << 5)); }
__host__ __device__ __forceinline__ void stage_rc(int b, int& R, int& C) { const int st = b / 1024, sb = b % 1024, swz = sb ^ (((sb >> 9) & 1) << 5); R = (st >> 1) * 16 + swz / 64; C = (st & 1) * 32 + (swz % 64) / 2; }
__host__ __device__ __forceinline__ int perm32(int rho) { const int n = rho >> 4, i = rho & 15; return 8 * (i >> 2) + 4 * n + (i & 3); }

struct Unit { int pm, pn; };
struct Gemm { const bf16_t* A; const bf16_t* Bt; int lda, ldb, M, N, K; };

struct StaticOrder {
    int nM, nN, nwg, G, c;
    __host__ __device__ void init(int M, int N, int G_, int c_) { nM = M / BM; nN = N / BM; nwg = nM * nN; G = G_; c = c_; }
    __host__ __device__ bool next(int i, Unit& u) const {
        const long L = (long)i * G + c; if (L >= nwg) return false;
        int wgid = (int)L; { const int q = nwg / NXCD, r = nwg % NXCD, xcd = wgid % NXCD, off = wgid / NXCD; wgid = (xcd < r ? xcd * (q + 1) : r * (q + 1) + (xcd - r) * q) + off; }
        const int nig = WGM * nN, gid = wgid / nig, fm = gid * WGM, gsz = (nM - fm) < WGM ? (nM - fm) : WGM;
        u.pm = fm + ((wgid % nig) % gsz); u.pn = (wgid % nig) / gsz; return true;
    }
};

enum { EM_SWIGLU = 0, EM_RES = 1, EM_QKV = 2, EM_GATE = 3, EM_MERGE = 4, EM_STORE = 5, EM_PLE = 6 };
struct Epi {
    static constexpr bool PERM = true;
    int mode; int flag; float scale;
    const GAS float* ssq_in; GAS float* ssq_out; GAS float* h; GAS bf16_t* o16; GAS float* mf; const GAS bf16_t* g16;
    const GAS bf16_t* hin; GAS bf16_t* lo; int fin;
    const GAS float *gfox, *gdiff, *cosT, *sinT, *bfg; GAS float* logf;

    __device__ __forceinline__ void operator()(const f32x4 (&acc)[2][2][4][2], const Unit& u, int wr, int wc, int fr, int fq) const {
        const int rowb = u.pm * BM + wr * 64 + fr;
        if (mode == EM_SWIGLU) {
            const int colh = u.pn * 128 + wc * 32 + fq * 8;
            float rsv[2][4];
#pragma unroll
            for (int ai = 0; ai < 2; ++ai)
#pragma unroll
                for (int m = 0; m < 4; ++m) rsv[ai][m] = ssq_in[rowb + ai * HALF + m * 16];
#pragma unroll
            for (int ai = 0; ai < 2; ++ai)
#pragma unroll
                for (int m = 0; m < 4; ++m) {
                    const int row = rowb + ai * HALF + m * 16;
                    const float rstd = __builtin_amdgcn_rsqf(rsv[ai][m] * (1.0f / DM) + EPS);
                    f32x4 o[2];
#pragma unroll
                    for (int n = 0; n < 2; ++n) { const f32x4 a = acc[ai][0][m][n] * rstd, g = acc[ai][1][m][n] * rstd; o[n] = a * sig4(a) * g; }
                    *(GAS u32x4*)(o16 + (size_t)row * DFF + colh) = pack8(o[0], o[1]);
                }
        } else if (mode == EM_RES || mode == EM_PLE) {
#pragma unroll
            for (int ai = 0; ai < 2; ++ai)
#pragma unroll
                for (int m = 0; m < 4; ++m) {
                    const int row = rowb + ai * HALF + m * 16;
                    float rstd = 1.f; if (mode == EM_PLE) rstd = __builtin_amdgcn_rsqf(ssq_in[row] * (1.0f / DM) + EPS);
                    float ss = 0.f;
#pragma unroll
                    for (int bj = 0; bj < 2; ++bj) {
                        const size_t off = (size_t)row * DM + u.pn * BM + bj * HALF + wc * 32 + fq * 8;
                        f32x4 h0, h1, l0, l1; unpack8(*(const GAS u32x4*)(hin + off), h0, h1); unpack8(*(const GAS u32x4*)(lo + off), l0, l1);
                        h0 += l0; h1 += l1;
                        if (mode == EM_PLE) { f32x4 t0, t1; unpack8(*(const GAS u32x4*)(g16 + off), t0, t1);
                            h0 += sig4(acc[ai][bj][m][0] * rstd) * t0; h1 += sig4(acc[ai][bj][m][1] * rstd) * t1; }
                        else { h0 += acc[ai][bj][m][0] * scale; h1 += acc[ai][bj][m][1] * scale; }
                        if (fin) { *(GAS f32x4*)(h + off) = h0; *(GAS f32x4*)(h + off + 4) = h1; }
                        const u32x4 hw = pack8(h0, h1); f32x4 g0, g1; unpack8(hw, g0, g1);
                        *(GAS u32x4*)(o16 + off) = hw;
                        *(GAS u32x4*)(lo + off) = pack8(h0 - g0, h1 - g1);
                        ss += dot4(h0) + dot4(h1);
                    }
                    ss += __shfl_xor(ss, 16); ss += __shfl_xor(ss, 32);
                    if (fq == 0) (void)__hip_atomic_fetch_add(ssq_out + row, ss, __ATOMIC_RELAXED, __HIP_MEMORY_SCOPE_AGENT);
                }
        } else if (mode == EM_QKV) {
            const int T = u.pn;
            if (T == 12) {
                if (wc == 0 && fq == 0) {
                    const f32x4 bf = *(const GAS f32x4*)bfg;
#pragma unroll
                    for (int ai = 0; ai < 2; ++ai)
#pragma unroll
                        for (int m = 0; m < 4; ++m) {
                            const int row = rowb + ai * HALF + m * 16;
                            const float rstd = __builtin_amdgcn_rsqf(ssq_in[row] * (1.0f / DM) + EPS);
                            const f32x4 v = acc[ai][0][m][0] * rstd + bf; f32x4 o;
#pragma unroll
                            for (int i = 0; i < 4; ++i) o[i] = (fminf(v[i], 0.f) * L2E - __builtin_amdgcn_logf(1.0f + __builtin_amdgcn_exp2f(-fabsf(v[i]) * L2E)));
                            *(GAS f32x4*)(logf + (size_t)row * 4) = o;
                        }
                }
                return;
            }
            const bool do_norm = (T == 3 || T == 4 || (T >= 6 && T <= 9)), do_rope = (T >= 6 && T <= 9);
            const GAS float* gain = (T == 3) ? gfox : (T == 4) ? gfox + 64 : (T == 6 || T == 7) ? gdiff : gdiff + 64;
            const float sc = (T == 0 || T == 3 || T == 6 || T == 7) ? C2 : 1.0f;
            f32x4 gv[2][2];
#pragma unroll
            for (int bj = 0; bj < 2; ++bj)
#pragma unroll
                for (int n = 0; n < 2; ++n) gv[bj][n] = do_norm ? *(const GAS f32x4*)(gain + 32 * bj + 8 * fq + 4 * n) : (f32x4){1.f, 1.f, 1.f, 1.f};
            float rsq[2][4];
#pragma unroll
            for (int ai = 0; ai < 2; ++ai)
#pragma unroll
                for (int m = 0; m < 4; ++m) rsq[ai][m] = ssq_in[rowb + ai * HALF + m * 16];
#pragma unroll
            for (int ai = 0; ai < 2; ++ai)
#pragma unroll
                for (int m = 0; m < 4; ++m) {
                    const int row = rowb + ai * HALF + m * 16;
                    const float rstd = __builtin_amdgcn_rsqf(rsq[ai][m] * (1.0f / DM) + EPS);
                    f32x4 x[2][2];
#pragma unroll
                    for (int bj = 0; bj < 2; ++bj)
#pragma unroll
                        for (int n = 0; n < 2; ++n) x[bj][n] = acc[ai][bj][m][n] * rstd;
                    if (do_norm) {
                        float ss = (dot4(x[0][0]) + dot4(x[0][1])) + (dot4(x[1][0]) + dot4(x[1][1]));
                        ss += __shfl_xor(ss, 16); ss += __shfl_xor(ss, 32);
                        const float rn = __builtin_amdgcn_rsqf(ss * (1.0f / 64.0f) + EPS);
#pragma unroll
                        for (int bj = 0; bj < 2; ++bj)
#pragma unroll
                            for (int n = 0; n < 2; ++n) x[bj][n] = x[bj][n] * rn * gv[bj][n];
                    }
                    if (do_rope) {
#pragma unroll
                        for (int n = 0; n < 2; ++n) {
                            f32x4 pr; pr[0] = __shfl_xor(x[0][n][0], 16); pr[1] = __shfl_xor(x[0][n][1], 16); pr[2] = __shfl_xor(x[0][n][2], 16); pr[3] = __shfl_xor(x[0][n][3], 16);
                            const f32x4 c = *(const GAS f32x4*)(cosT + (size_t)row * 8 + 4 * n), s = *(const GAS f32x4*)(sinT + (size_t)row * 8 + 4 * n);
                            if (fq == 0) x[0][n] = x[0][n] * c - pr * s; else if (fq == 1) x[0][n] = x[0][n] * c + pr * s;
                        }
                    }
#pragma unroll
                    for (int bj = 0; bj < 2; ++bj)
                        *(GAS u32x4*)(o16 + (size_t)row * NQKV + T * 256 + wc * 64 + bj * 32 + fq * 8) = pack8(x[bj][0] * sc, x[bj][1] * sc);
                }
        } else if (mode == EM_GATE) {
            float rsg[2][4];
#pragma unroll
            for (int ai = 0; ai < 2; ++ai)
#pragma unroll
                for (int m = 0; m < 4; ++m) rsg[ai][m] = ssq_in[rowb + ai * HALF + m * 16];
#pragma unroll
            for (int ai = 0; ai < 2; ++ai)
#pragma unroll
                for (int m = 0; m < 4; ++m) {
                    const int row = rowb + ai * HALF + m * 16;
                    const float rstd = __builtin_amdgcn_rsqf(rsg[ai][m] * (1.0f / DM) + EPS);
#pragma unroll
                    for (int bj = 0; bj < 2; ++bj) {
                        const size_t off = (size_t)row * DM + u.pn * BM + bj * HALF + wc * 32 + fq * 8;
                        *(GAS u32x4*)(o16 + off) = pack8(sig4(acc[ai][bj][m][0] * rstd), sig4(acc[ai][bj][m][1] * rstd));
                    }
                }
        } else {
#pragma unroll
            for (int ai = 0; ai < 2; ++ai)
#pragma unroll
                for (int m = 0; m < 4; ++m) {
                    const int row = rowb + ai * HALF + m * 16;
                    float rstd = 1.f; if (mode == EM_GATE) rstd = __builtin_amdgcn_rsqf(ssq_in[row] * (1.0f / DM) + EPS);
#pragma unroll
                    for (int bj = 0; bj < 2; ++bj) {
                        const size_t off = (size_t)row * DM + u.pn * BM + bj * HALF + wc * 32 + fq * 8;
                        if (mode == EM_GATE) { *(GAS u32x4*)(o16 + off) = pack8(sig4(acc[ai][bj][m][0] * rstd), sig4(acc[ai][bj][m][1] * rstd)); }
                        else if (mode == EM_STORE) { *(GAS u32x4*)(o16 + off) = pack8(acc[ai][bj][m][0], acc[ai][bj][m][1]); }
                        else {
                            f32x4 g0, g1; unpack8(*(const GAS u32x4*)(g16 + off), g0, g1);
                            f32x4 v0 = g0 * acc[ai][bj][m][0], v1 = g1 * acc[ai][bj][m][1];
                            GAS bf16_t* mf16 = (GAS bf16_t*)mf;
                            if (flag > 0) { f32x4 a0, a1; unpack8(*(const GAS u32x4*)(mf16 + off), a0, a1); v0 += a0; v1 += a1; }
                            if (flag < 2) *(GAS u32x4*)(mf16 + off) = pack8(v0, v1);
                            else *(GAS u32x4*)(o16 + off) = pack8(v0, v1);
                        }
                    }
                }
        }
    }
};

__device__ __forceinline__ void gemm_phase(LAS unsigned char* lds, const Gemm g, const StaticOrder& S, const Epi& E) {
    int tid_ = threadIdx.x; asm volatile("" : "+v"(tid_));
    const int tid = tid_, wid = __builtin_amdgcn_readfirstlane(tid >> 6), lane = tid & 63, wr = wid >> 2, wc = wid & 3, fr = lane & 15, fq = lane >> 4;
    const int K = g.K, nt = K / BK;
    unsigned voffA[2], voffB[2];
#pragma unroll
    for (int i = 0; i < 2; ++i) { int R, C; stage_rc(tid * 16 + i * 8192, R, C); const int Rb = ((R & ~31) + perm32(R & 31));
        voffA[i] = (unsigned)(R * g.lda + C) * 2u; voffB[i] = (unsigned)(Rb * g.ldb + C) * 2u; }
    const size_t kstep = (size_t)(BK * 2);
    const size_t hstepA = (size_t)HALF * g.lda * 2, hstepB = (size_t)HALF * g.ldb * 2;
    const size_t tstepA = 2 * hstepA, tstepB = 2 * hstepB;
    const unsigned ldsw = (unsigned)wid * 1024u;
    const int aoff = lds_byte(wr * 64 + fr, fq * 8), boff = lds_byte(wc * 32 + fr, fq * 8);
#define PG8_SA(b, h) (((b) * 2 + (h)) * HTB)
#define PG8_SB(b, h) ((4 + (b) * 2 + (h)) * HTB)
#define PG8_STAGE(bufoff, gbase, voff) do { _Pragma("unroll") for (int _i = 0; _i < 2; ++_i) \
        __builtin_amdgcn_global_load_lds((const unsigned*)((const char*)(gbase) + (voff)[_i]), (LAS unsigned*)(lds + (bufoff) + ldsw + _i * 8192), 16, 0, 0); } while (0)
#define PG8_LDA(dst, b, h) do { _Pragma("unroll") for (int m = 0; m < 4; ++m) _Pragma("unroll") for (int k = 0; k < 2; ++k) dst[m][k] = *(const LAS bf16x8*)(lds + PG8_SA(b, h) + aoff + m * 2048 + k * 1024); } while (0)
#define PG8_LDB(dst, b, h) do { _Pragma("unroll") for (int n = 0; n < 2; ++n) _Pragma("unroll") for (int k = 0; k < 2; ++k) dst[n][k] = *(const LAS bf16x8*)(lds + PG8_SB(b, h) + boff + n * 2048 + k * 1024); } while (0)
#define PG8_MMA(ai, bj, At, Bt) do { __builtin_amdgcn_s_setprio(1); _Pragma("unroll") for (int m = 0; m < 4; ++m) _Pragma("unroll") for (int n = 0; n < 2; ++n) _Pragma("unroll") for (int k = 0; k < 2; ++k) \
        acc[ai][bj][m][n] = __builtin_amdgcn_mfma_f32_16x16x32_bf16(Bt[n][k], At[m][k], acc[ai][bj][m][n], 0, 0, 0); __builtin_amdgcn_s_setprio(0); } while (0)
#define PG8_WAIT_V(n) asm volatile("s_waitcnt vmcnt(" #n ")" ::: "memory")
#define PG8_WAIT_L(n) asm volatile("s_waitcnt lgkmcnt(" #n ")" ::: "memory")
#define PG8_BAR __builtin_amdgcn_s_barrier()
#define PG8_SCHED __builtin_amdgcn_sched_barrier(0)
    Unit cur, nxt; int ui = 0;
    if (!S.next(0, cur)) return;
    f32x4 acc[2][2][4][2];
#pragma unroll
    for (int a = 0; a < 2; ++a)
#pragma unroll
        for (int b = 0; b < 2; ++b)
#pragma unroll
            for (int m = 0; m < 4; ++m)
#pragma unroll
                for (int n = 0; n < 2; ++n) acc[a][b][m][n] = (f32x4){0.f, 0.f, 0.f, 0.f};
    bf16x8 At[4][2], B0[2][2], B1[2][2];
    const char* cA = (const char*)g.A + (size_t)cur.pm * tstepA; const char* cB = (const char*)g.Bt + (size_t)cur.pn * tstepB;
    PG8_STAGE(PG8_SB(0, 0), cB, voffB); PG8_STAGE(PG8_SB(0, 1), cB + hstepB, voffB); PG8_STAGE(PG8_SA(0, 0), cA, voffA); PG8_STAGE(PG8_SA(0, 1), cA + hstepA, voffA);
    if (wr == 1) PG8_BAR;
    PG8_WAIT_V(2); PG8_BAR;
    PG8_STAGE(PG8_SB(1, 0), cB + kstep, voffB); PG8_STAGE(PG8_SA(1, 0), cA + kstep, voffA); PG8_STAGE(PG8_SB(1, 1), cB + hstepB + kstep, voffB);
    PG8_WAIT_V(6); PG8_BAR;
    for (;;) {
        const bool has_next = S.next(ui + 1, nxt);
        const char* nA = has_next ? (const char*)g.A + (size_t)nxt.pm * tstepA : cA; const char* nB = has_next ? (const char*)g.Bt + (size_t)nxt.pn * tstepB : cB;
        for (int t = 0; t < nt; t += 2) {
            const bool last = (t == nt - 2);
            const char* a1 = cA + (size_t)(t + 1) * kstep;
            const char* a2 = last ? nA : cA + (size_t)(t + 2) * kstep; const char* b2 = last ? nB : cB + (size_t)(t + 2) * kstep;
            const char* a3 = a2 + kstep; const char* b3 = b2 + kstep;
            PG8_LDB(B0, 0, 0); PG8_LDB(B1, 0, 1); PG8_SCHED; PG8_LDA(At, 0, 0); PG8_STAGE(PG8_SA(1, 1), a1 + hstepA, voffA);
            PG8_WAIT_V(8); PG8_WAIT_L(0); PG8_BAR; PG8_MMA(0, 0, At, B0); PG8_MMA(0, 1, At, B1); PG8_BAR; PG8_SCHED;
            PG8_LDA(At, 0, 1); PG8_STAGE(PG8_SB(0, 0), b2, voffB); PG8_STAGE(PG8_SB(0, 1), b2 + hstepB, voffB); PG8_STAGE(PG8_SA(0, 0), a2, voffA);
            PG8_WAIT_V(8); PG8_WAIT_L(0); PG8_BAR; PG8_MMA(1, 0, At, B0); PG8_MMA(1, 1, At, B1); PG8_BAR; PG8_SCHED;
            PG8_LDB(B0, 1, 0); PG8_LDB(B1, 1, 1); PG8_SCHED; PG8_LDA(At, 1, 0); PG8_STAGE(PG8_SA(0, 1), a2 + hstepA, voffA);
            PG8_WAIT_V(8); PG8_WAIT_L(0); PG8_BAR; PG8_MMA(0, 0, At, B0); PG8_MMA(0, 1, At, B1); PG8_BAR; PG8_SCHED;
            PG8_LDA(At, 1, 1); PG8_STAGE(PG8_SB(1, 0), b3, voffB); PG8_STAGE(PG8_SB(1, 1), b3 + hstepB, voffB); PG8_STAGE(PG8_SA(1, 0), a3, voffA);
            PG8_WAIT_V(8); PG8_WAIT_L(0); PG8_BAR; PG8_MMA(1, 0, At, B0); PG8_MMA(1, 1, At, B1); PG8_BAR; PG8_SCHED;
        }
        if (wr == 0) PG8_BAR;
        E(acc, cur, wr, wc, fr, fq);
        if (!has_next) break;
#pragma unroll
        for (int a = 0; a < 2; ++a)
#pragma unroll
            for (int b = 0; b < 2; ++b)
#pragma unroll
                for (int m = 0; m < 4; ++m)
#pragma unroll
                    for (int n = 0; n < 2; ++n) acc[a][b][m][n] = (f32x4){0.f, 0.f, 0.f, 0.f};
        cur = nxt; cA = nA; cB = nB; ++ui;
        if (wr == 1) PG8_BAR;
    }
    PG8_WAIT_V(0);
    PG8_BAR;
#undef PG8_SA
#undef PG8_SB
#undef PG8_STAGE
#undef PG8_LDA
#undef PG8_LDB
#undef PG8_MMA
#undef PG8_WAIT_V
#undef PG8_WAIT_L
#undef PG8_BAR
#undef PG8_SCHED
}
}

namespace att {
constexpr int PITCH = NQKV, AOP = DM;
constexpr int LK = 0, LV = 16384, LWS = 65536, LOST = 67584, LCUM = LOST + 32768, LMISC = 133120;
__device__ __forceinline__ int crow(int r, int hi) { return (r & 3) + 8 * (r >> 2) + 4 * hi; }
__device__ __forceinline__ float partner32(float x, int hi) { auto rr = __builtin_amdgcn_permlane32_swap(__float_as_uint(x), __float_as_uint(x), false, false); return __uint_as_float(hi ? rr[0] : rr[1]); }
__device__ __forceinline__ float rowmax(const f32x16& p0, const f32x16& p1) {
    float a = fmaxf(fmaxf(p0[0], p0[1]), p1[0]), b = fmaxf(fmaxf(p0[2], p0[3]), p1[1]); a = fmaxf(fmaxf(a, p1[2]), p1[3]);
#pragma unroll
    for (int r = 4; r < 16; r += 4) { a = fmaxf(fmaxf(a, p0[r]), p0[r + 1]); b = fmaxf(fmaxf(b, p0[r + 2]), p0[r + 3]); a = fmaxf(fmaxf(a, p1[r]), p1[r + 1]); b = fmaxf(fmaxf(b, p1[r + 2]), p1[r + 3]); }
    const float m = fmaxf(a, b);
    auto rr = __builtin_amdgcn_permlane32_swap(__float_as_uint(m), __float_as_uint(m), false, false);
    return fmaxf(__uint_as_float(rr[0]), __uint_as_float(rr[1]));
}
__device__ __forceinline__ void qkt(f32x16& p0, f32x16& p1, const LAS char* kb, const bf16x8* qr, const f32x16& cinit) {
#pragma unroll
    for (int d0 = 0; d0 < 4; ++d0) {
        const bf16x8 b0 = *(const LAS bf16x8*)(kb + d0 * 2048);
        const bf16x8 b1 = *(const LAS bf16x8*)(kb + d0 * 2048 + 512);
        if (d0 == 0) { p0 = __builtin_amdgcn_mfma_f32_32x32x16_bf16(b0, qr[0], cinit, 0, 0, 0); p1 = __builtin_amdgcn_mfma_f32_32x32x16_bf16(b1, qr[0], cinit, 0, 0, 0); }
        else { p0 = __builtin_amdgcn_mfma_f32_32x32x16_bf16(b0, qr[d0], p0, 0, 0, 0); p1 = __builtin_amdgcn_mfma_f32_32x32x16_bf16(b1, qr[d0], p1, 0, 0, 0); }
    }
}
__device__ __forceinline__ void pv(f32x16* o, int vb, bf16x8 pa0, bf16x8 pa1, bf16x8 pa2, bf16x8 pa3) {
    s16x4 lo[2][4], hi[2][4];
#pragma unroll
    for (int d0 = 0; d0 < 2; ++d0)
#pragma unroll
        for (int ks = 0; ks < 4; ++ks) {
            asm volatile("ds_read_b64_tr_b16 %0,%1 offset:%c2" : "=&v"(lo[d0][ks]) : "v"(vb), "i"(d0 * 4096 + ks * 1024) : "memory");
            asm volatile("ds_read_b64_tr_b16 %0,%1 offset:%c2" : "=&v"(hi[d0][ks]) : "v"(vb), "i"(d0 * 4096 + ks * 1024 + 512) : "memory"); }
    asm volatile("s_waitcnt lgkmcnt(0)" ::: "memory"); __builtin_amdgcn_sched_barrier(0);
#define PK(d, k) (bf16x8){lo[d][k][0], lo[d][k][1], lo[d][k][2], lo[d][k][3], hi[d][k][0], hi[d][k][1], hi[d][k][2], hi[d][k][3]}
    o[0] = __builtin_amdgcn_mfma_f32_32x32x16_bf16(pa0, PK(0, 0), o[0], 0, 0, 0); o[1] = __builtin_amdgcn_mfma_f32_32x32x16_bf16(pa0, PK(1, 0), o[1], 0, 0, 0);
    o[0] = __builtin_amdgcn_mfma_f32_32x32x16_bf16(pa1, PK(0, 1), o[0], 0, 0, 0); o[1] = __builtin_amdgcn_mfma_f32_32x32x16_bf16(pa1, PK(1, 1), o[1], 0, 0, 0);
    o[0] = __builtin_amdgcn_mfma_f32_32x32x16_bf16(pa2, PK(0, 2), o[0], 0, 0, 0); o[1] = __builtin_amdgcn_mfma_f32_32x32x16_bf16(pa2, PK(1, 2), o[1], 0, 0, 0);
    o[0] = __builtin_amdgcn_mfma_f32_32x32x16_bf16(pa3, PK(0, 3), o[0], 0, 0, 0); o[1] = __builtin_amdgcn_mfma_f32_32x32x16_bf16(pa3, PK(1, 3), o[1], 0, 0, 0);
#undef PK
}

template <int MODE, bool NOMAX = false>
__device__ __forceinline__ void attn_unit(int b, int h, int qb, const GAS bf16_t* __restrict__ QKV, GAS bf16_t* __restrict__ AO, const GAS float* __restrict__ logf,
                                          const GAS float* __restrict__ subln, float lam, float oscale, LAS unsigned char* shm) {
    constexpr int DV = (MODE == 2) ? 128 : 64, NPASS = (MODE == 2) ? 2 : 1, ND = DV / 32;
    int tid_ = threadIdx.x; asm volatile("" : "+v"(tid_));
    const int tid = tid_, lane = tid & 63, r32 = lane & 31, hi = lane >> 5; const int wid = __builtin_amdgcn_readfirstlane(tid >> 6);
    const long rowbase = (long)b * SEQ; const int q0 = qb * 256;
    const int qcol = MODE == 0 ? h * 64 : MODE == 1 ? 768 + h * 64 : 1536 + h * 128;
    const int kcol = MODE == 0 ? 256 + h * 64 : MODE == 1 ? 1024 + h * 64 : 2048 + h * 128;
    const int vcol = MODE == 0 ? 512 + h * 64 : MODE == 1 ? 1280 + h * 64 : 2560 + h * 128;
    const int ocol = MODE == 0 ? h * 64 : MODE == 1 ? 256 + h * 64 : 512 + h * 128;
    const int NT = 4 * qb + 4, ktmax_w = 4 * qb + (wid >> 1);
    const unsigned lds0 = (unsigned)(uintptr_t)shm;
    LAS float* wsf = (LAS float*)(shm + LWS) + wid * 64;
    LAS float* cum = (LAS float*)(shm + LCUM);
    const int trel = 32 * (wid & 1) + r32;
    float cq = 0.f; int it0 = 0;
    if (MODE == 1) {
        const int n = q0 + 256, base = tid * 8; float v[8];
#pragma unroll
        for (int i = 0; i < 8; ++i) { const int s = base + i; v[i] = (s < n) ? logf[(size_t)(rowbase + s) * 4 + h] : 0.f; }
#pragma unroll
        for (int i = 1; i < 8; ++i) v[i] += v[i - 1];
        float inc = v[7];
#pragma unroll
        for (int o = 1; o < 64; o <<= 1) { const float t = __shfl_up(inc, o); if (lane >= o) inc += t; }
        LAS float* wt = (LAS float*)(shm + LMISC) + 16;
        if (lane == 63) wt[wid] = inc;
        __syncthreads();
        float woff = 0.f;
#pragma unroll
        for (int w = 0; w < 8; ++w) woff += (w < wid) ? wt[w] : 0.f;
        const float toff = woff + inc - v[7];
#pragma unroll
        for (int i = 0; i < 8; ++i) cum[base + i] = v[i] + toff;
        __syncthreads();
        cq = cum[q0 + wid * 32 + r32];
        float gq = fabsf(subln[lane]), gk = fabsf(subln[64 + lane]);
#pragma unroll
        for (int o = 1; o < 64; o <<= 1) { gq = fmaxf(gq, __shfl_xor(gq, o)); gk = fmaxf(gk, __shfl_xor(gk, o)); }
        const float Bb = 64.0f * C2 * gq * gk * 1.03f + 1.0f, thr = -(2.0f * Bb + 150.0f), c0 = cum[q0];
        while (it0 < NT - 4 && (c0 - cum[64 * it0 + 63]) < thr) ++it0;
        it0 = __builtin_amdgcn_readfirstlane(it0);
    }
    GAS bf16_t* Ow = AO + (size_t)(rowbase + q0 + wid * 32) * AOP + ocol;
    LAS bf16_t* stg = (LAS bf16_t*)(shm + LOST) + wid * (DV * 32);
#pragma unroll
    for (int pass = 0; pass < NPASS; ++pass) {
        const GAS bf16_t* Qw = QKV + (size_t)(rowbase + q0 + wid * 32) * PITCH + qcol + pass * 64;
        const GAS bf16_t* ksrc = QKV + (size_t)(rowbase + lane) * PITCH + kcol + pass * 64 + wid * 8;
        const GAS bf16_t* vsrc = QKV + (size_t)(rowbase + 16 * (wid & 3) + (lane >> 2)) * PITCH + vcol + (wid >> 2) * 32 + (lane & 3) * 8;
        bf16x8 qr[4];
#pragma unroll
        for (int d0 = 0; d0 < 4; ++d0) qr[d0] = *(const GAS bf16x8*)(Qw + (size_t)r32 * PITCH + d0 * 16 + hi * 8);
        float mhat = 0.f, l_reg = 0.f, carry = 0.f;
        f32x16 o[ND];
#pragma unroll
        for (int d = 0; d < ND; ++d) o[d] = f32x16{};
        u32x4 kreg, vreg0, vreg1 = u32x4{};
        { const int kt = (MODE == 0) ? NT - 1 : it0; const size_t go = (size_t)kt * 64 * PITCH;
          kreg = *(const GAS u32x4*)(ksrc + go); vreg0 = *(const GAS u32x4*)(vsrc + go); if (DV == 128) vreg1 = *(const GAS u32x4*)(vsrc + go + 64); }
        u32x4 pw0 = u32x4{}, pw1 = u32x4{}, pw2 = u32x4{}, pw3 = u32x4{};
        const bool lag = (wid >= 4); bool pend = false; int vs = 0, vsp = 0;
        const int vbl = (int)(lds0 + LV) + ((lane >> 4) & 1) * 32 + (lane & 3) * 8 + (4 * hi + ((lane & 15) >> 2)) * 64;
#define ATT_PV(VB_) do { pv(o, (VB_), __builtin_bit_cast(bf16x8, pw0), __builtin_bit_cast(bf16x8, pw1), __builtin_bit_cast(bf16x8, pw2), __builtin_bit_cast(bf16x8, pw3)); \
            if (DV == 128) pv(o + 2, (VB_) + 8192, __builtin_bit_cast(bf16x8, pw0), __builtin_bit_cast(bf16x8, pw1), __builtin_bit_cast(bf16x8, pw2), __builtin_bit_cast(bf16x8, pw3)); } while (0)
        {   *(LAS u32x4*)(shm + LK + (it0 & 1) * 8192 + wid * 1024 + lane * 16) = kreg;
            *(LAS u32x4*)(shm + LV + wid * 1024 + lane * 16) = vreg0;
            if (DV == 128) *(LAS u32x4*)(shm + LV + 8192 + wid * 1024 + lane * 16) = vreg1;
            const int kt1 = (MODE == 0) ? NT - 2 - it0 : it0 + 1; const size_t go = (size_t)kt1 * 64 * PITCH;
            kreg = *(const GAS u32x4*)(ksrc + go); vreg0 = *(const GAS u32x4*)(vsrc + go); if (DV == 128) vreg1 = *(const GAS u32x4*)(vsrc + go + 64); }
        for (int it = it0; it < NT; ++it) {
            const int kt = (MODE == 0) ? NT - 1 - it : it, slot = it & 1;
            const int vsn = (vs == 2) ? 0 : vs + 1;
            __syncthreads();
            if (it + 1 < NT) {
                *(LAS u32x4*)(shm + LK + (slot ^ 1) * 8192 + wid * 1024 + lane * 16) = kreg;
                *(LAS u32x4*)(shm + LV + vsn * 16384 + wid * 1024 + lane * 16) = vreg0;
                if (DV == 128) *(LAS u32x4*)(shm + LV + vsn * 16384 + 8192 + wid * 1024 + lane * 16) = vreg1; }
            if (it + 2 < NT) { const int ktn = (MODE == 0) ? kt - 2 : kt + 2; const size_t go = (size_t)ktn * 64 * PITCH;
                kreg = *(const GAS u32x4*)(ksrc + go); vreg0 = *(const GAS u32x4*)(vsrc + go); if (DV == 128) vreg1 = *(const GAS u32x4*)(vsrc + go + 64); }
            if (lag && pend) { ATT_PV(vbl + vsp * 16384); pend = false; }
            bool wdone = false;
            if (kt <= ktmax_w) {
                const LAS char* kb = (const LAS char*)(shm + LK + slot * 8192) + hi * 1024 + r32 * 16;
                const bool diag = (kt == ktmax_w);
                f32x16 p0, p1;
                if (MODE == 0) {
                    f32x16 cz = f32x16{}; asm volatile("" : "+v"(cz));
                    qkt(p0, p1, kb, qr, cz);
                    f32x16 L0, L1;
#pragma unroll
                    for (int r = 0; r < 16; ++r) {
                        const float z0 = p0[r], z1 = p1[r];
                        L0[r] = -__builtin_amdgcn_logf(1.0f + __builtin_amdgcn_exp2f(-z0)) - z0;
                        L1[r] = -__builtin_amdgcn_logf(1.0f + __builtin_amdgcn_exp2f(-z1)) - z1;
                    }
                    if (diag) {
#pragma unroll
                        for (int r = 0; r < 16; ++r) { const int kv = crow(r, hi);
                            if (kv >= trel) { L0[r] = 0.f; p0[r] = -INFINITY; }
                            if (kv + 32 >= trel) { L1[r] = 0.f; p1[r] = -INFINITY; } }
                    }
                    float T0[4], T1[4], PG0[4], PG1[4];
#pragma unroll
                    for (int g = 0; g < 4; ++g) {
                        const float g0 = (L0[4 * g] + L0[4 * g + 1]) + (L0[4 * g + 2] + L0[4 * g + 3]), g1 = (L1[4 * g] + L1[4 * g + 1]) + (L1[4 * g + 2] + L1[4 * g + 3]);
                        PG0[g] = partner32(g0, hi); PG1[g] = partner32(g1, hi); T0[g] = g0 + PG0[g]; T1[g] = g1 + PG1[g];
                    }
                    const float tot1 = (T1[0] + T1[1]) + (T1[2] + T1[3]), tot0 = (T0[0] + T0[1]) + (T0[2] + T0[3]);
                    float ST1[4], ST0[4];
                    ST1[3] = 0.f; ST1[2] = T1[3]; ST1[1] = ST1[2] + T1[2]; ST1[0] = ST1[1] + T1[1];
                    ST0[3] = tot1; ST0[2] = ST0[3] + T0[3]; ST0[1] = ST0[2] + T0[2]; ST0[0] = ST0[1] + T0[1];
#pragma unroll
                    for (int g = 0; g < 4; ++g) {
                        const float b0 = carry + ST0[g] + (hi == 0 ? PG0[g] : 0.f), b1 = carry + ST1[g] + (hi == 0 ? PG1[g] : 0.f);
                        L0[4 * g + 3] += b0; L0[4 * g + 2] += L0[4 * g + 3]; L0[4 * g + 1] += L0[4 * g + 2]; L0[4 * g] += L0[4 * g + 1];
                        L1[4 * g + 3] += b1; L1[4 * g + 2] += L1[4 * g + 3]; L1[4 * g + 1] += L1[4 * g + 2]; L1[4 * g] += L1[4 * g + 1];
                    }
#pragma unroll
                    for (int r = 0; r < 16; ++r) { p0[r] = __builtin_amdgcn_exp2f(p0[r] + L0[r]); p1[r] = __builtin_amdgcn_exp2f(p1[r] + L1[r]); }
                    carry += tot0 + tot1;
                    wdone = !__any(!(carry < -150.f));
                } else {
                    f32x16 negm;
                    { const float nm = NOMAX ? cq : cq - mhat;
#pragma unroll
                      for (int r = 0; r < 16; ++r) negm[r] = nm; }
                    asm volatile("" : "+v"(negm));
                    qkt(p0, p1, kb, qr, negm);
                    if (MODE == 1) {
#pragma unroll
                        for (int g = 0; g < 4; ++g) {
                            const f32x4 c0 = *(const LAS f32x4*)(cum + kt * 64 + 8 * g + 4 * hi), c1 = *(const LAS f32x4*)(cum + kt * 64 + 32 + 8 * g + 4 * hi);
#pragma unroll
                            for (int i = 0; i < 4; ++i) { p0[4 * g + i] -= c0[i]; p1[4 * g + i] -= c1[i]; }
                        }
                        if (diag) {
#pragma unroll
                            for (int r = 0; r < 16; ++r) { const int kv = crow(r, hi); if (kv > trel) p0[r] = -INFINITY; if (kv + 32 > trel) p1[r] = -INFINITY; }
                        }
                    }
                    const float rm = NOMAX ? 0.f : rowmax(p0, p1);
                    if (NOMAX) {
                    } else if (it == it0) {
                        mhat = rm;
#pragma unroll
                        for (int r = 0; r < 16; ++r) { p0[r] -= rm; p1[r] -= rm; }
                    } else if (__any(rm > 8.0f)) {
                        const float dl = fmaxf(rm, 0.f); mhat += dl;
#pragma unroll
                        for (int r = 0; r < 16; ++r) { p0[r] -= dl; p1[r] -= dl; }
                        const float f = __builtin_amdgcn_exp2f(-dl); l_reg *= f;
                        if (hi == 0) wsf[r32] = f;
                        asm volatile("s_waitcnt lgkmcnt(0)" ::: "memory");
#pragma unroll
                        for (int g = 0; g < 4; ++g) { const f32x4 fv = *(const LAS f32x4*)(wsf + 8 * g + 4 * hi);
#pragma unroll
                            for (int d = 0; d < ND; ++d)
#pragma unroll
                                for (int i = 0; i < 4; ++i) o[d][4 * g + i] *= fv[i]; }
                    }
                    float sacc = 0.f;
#pragma unroll
                    for (int r = 0; r < 16; ++r) { p0[r] = __builtin_amdgcn_exp2f(p0[r]); p1[r] = __builtin_amdgcn_exp2f(p1[r]); sacc += p0[r] + p1[r]; }
                    l_reg += sacc;
                }
                pw0 = (u32x4){cvtpk(p0[0], p0[1]), cvtpk(p0[2], p0[3]), cvtpk(p0[4], p0[5]), cvtpk(p0[6], p0[7])};
                pw1 = (u32x4){cvtpk(p0[8], p0[9]), cvtpk(p0[10], p0[11]), cvtpk(p0[12], p0[13]), cvtpk(p0[14], p0[15])};
                pw2 = (u32x4){cvtpk(p1[0], p1[1]), cvtpk(p1[2], p1[3]), cvtpk(p1[4], p1[5]), cvtpk(p1[6], p1[7])};
                pw3 = (u32x4){cvtpk(p1[8], p1[9]), cvtpk(p1[10], p1[11]), cvtpk(p1[12], p1[13]), cvtpk(p1[14], p1[15])};
                if (!lag) ATT_PV(vbl + vs * 16384); else pend = true;
            }
            vsp = vs; vs = vsn;
            if (MODE == 0) { if (__syncthreads_and(wdone ? 1 : 0)) break; }
        }
        if (lag && pend) ATT_PV(vbl + vsp * 16384);
#undef ATT_PV
        if (MODE != 0) {
            const float lt = l_reg + partner32(l_reg, hi);
            if (hi == 0) wsf[32 + r32] = lt;
            asm volatile("s_waitcnt lgkmcnt(0)" ::: "memory");
#pragma unroll
            for (int g = 0; g < 4; ++g) { const f32x4 lv = *(const LAS f32x4*)(wsf + 32 + 8 * g + 4 * hi);
#pragma unroll
                for (int i = 0; i < 4; ++i) { const float rl = __builtin_amdgcn_rcpf(lv[i]);
#pragma unroll
                    for (int d = 0; d < ND; ++d) o[d][4 * g + i] *= rl; } }
        }
        if (MODE == 2 && pass == 0) {
#pragma unroll
            for (int r = 0; r < 16; ++r) { const int orow = crow(r, hi);
#pragma unroll
                for (int d = 0; d < ND; ++d) stg[orow * DV + d * 32 + r32] = (bf16_t)(cvtpk(o[d][r], 0.f) & 0xffffu); }
        }
        if (MODE == 2 && pass == 1) {
            float ssr[16];
#pragma unroll
            for (int r = 0; r < 16; ++r) ssr[r] = 0.f;
#pragma unroll
            for (int r = 0; r < 16; ++r) { const int orow = crow(r, hi);
#pragma unroll
                for (int d = 0; d < ND; ++d) { const float a0 = __uint_as_float((unsigned)stg[orow * DV + d * 32 + r32] << 16);
                    o[d][r] = a0 - lam * o[d][r]; ssr[r] += o[d][r] * o[d][r]; } }
#pragma unroll
            for (int r = 0; r < 16; ++r) {
#pragma unroll
                for (int x = 1; x < 32; x <<= 1) ssr[r] += __shfl_xor(ssr[r], x);
                ssr[r] = __builtin_amdgcn_rsqf(ssr[r] * (1.0f / 128.0f) + EPS) * oscale;
            }
#pragma unroll
            for (int d = 0; d < ND; ++d) { const float gsl = subln[d * 32 + r32];
#pragma unroll
                for (int r = 0; r < 16; ++r) o[d][r] *= ssr[r] * gsl; }
        }
        if (MODE != 2 || pass == 1) {
#pragma unroll
            for (int r = 0; r < 16; ++r) { const int orow = crow(r, hi);
#pragma unroll
                for (int d = 0; d < ND; ++d) stg[orow * DV + d * 32 + r32] = (bf16_t)(cvtpk(o[d][r], 0.f) & 0xffffu); }
            asm volatile("s_waitcnt lgkmcnt(0)" ::: "memory");
            if (DV == 64) {
#pragma unroll
                for (int i = 0; i < 4; ++i) { const int row = i * 8 + (lane >> 3), ch = lane & 7; const u32x4 v = *(const LAS u32x4*)(stg + row * 64 + ch * 8); *(GAS u32x4*)(Ow + (size_t)row * AOP + ch * 8) = v; }
            } else {
#pragma unroll
                for (int i = 0; i < 8; ++i) { const int row = i * 4 + (lane >> 4), ch = lane & 15; const u32x4 v = *(const LAS u32x4*)(stg + row * 128 + ch * 8); *(GAS u32x4*)(Ow + (size_t)row * AOP + ch * 8) = v; }
            }
        }
        __syncthreads();
    }
}
}

__device__ __forceinline__ float wave_sum(float v) {
#pragma unroll
    for (int o = 1; o < 64; o <<= 1) v += __shfl_xor(v, o);
    return v;
}
struct MatDesc { const float* src; const float* gain; bf16_t* dst; int ldw, K, Np, kind; };
__device__ __forceinline__ void xpose_item(const MatDesc& d, int item, LAS float* scr, int lane) {
    const int nblk = d.Np / 32, kb = item / nblk, nb = item % nblk, k0 = 64 * kb, n0 = 32 * nb;
    int sc = n0, nvalid = 32;
    if (d.kind == 1) { const int tile = n0 >> 8, w = n0 & 255; sc = (w < 128) ? 128 * tile + w : DFF + 128 * tile + (w - 128); }
    else if (d.kind == 2) { const int T = n0 >> 8, w = n0 & 255;
        if (T == 12) { sc = 1536; nvalid = (w == 0) ? 4 : 0; }
        else { const int hh = (w >> 5) & 3, dd = 32 * (w >> 7), L = 256 * T + 64 * hh + dd; sc = (L < 1536) ? L : L + 4; } }
    {
        const int r8 = lane >> 3, q = lane & 7; const bool ok = (4 * q < nvalid);
        f32x4 v[8];
#pragma unroll
        for (int i = 0; i < 8; ++i) v[i] = ok ? *(const f32x4*)(d.src + (size_t)(k0 + 8 * i + r8) * d.ldw + sc + 4 * q) : (f32x4){0.f, 0.f, 0.f, 0.f};
#pragma unroll
        for (int i = 0; i < 8; ++i) { const int kk = 8 * i + r8; const float gm = d.gain ? d.gain[k0 + kk] : 1.f;
            LAS float* sp = scr + kk * 33 + 4 * q; sp[0] = v[i][0] * gm; sp[1] = v[i][1] * gm; sp[2] = v[i][2] * gm; sp[3] = v[i][3] * gm; }
    }
    asm volatile("s_waitcnt lgkmcnt(0)" ::: "memory");
    const int c = lane & 7;
#pragma unroll
    for (int jj = 0; jj < 4; ++jj) { const int n = (lane >> 3) + 8 * jj; const LAS float* s = scr + (8 * c) * 33 + n;
        u32x4 o; o.x = cvtpk(s[0 * 33], s[1 * 33]); o.y = cvtpk(s[2 * 33], s[3 * 33]); o.z = cvtpk(s[4 * 33], s[5 * 33]); o.w = cvtpk(s[6 * 33], s[7 * 33]);
        *(u32x4*)(d.dst + (size_t)(n0 + n) * d.K + k0 + 8 * c) = o; }
    asm volatile("s_waitcnt lgkmcnt(0)" ::: "memory");
}

#define XB_TMO      128
#define XB_XCNT(j)  (256  + 64 * (j))
#define XB_XSUB(j)  (1280 + 64 * (j))
#define XB_XGEN(j)  (2304 + 64 * (j))
#define XB_TOP      3328
#define XB_TOPGEN   3392
#define XCD_BAR_WORDS 3456
#define XB_SPIN_CAP (1u << 18)
__device__ __forceinline__ unsigned xb_ld(unsigned* p)              { return __hip_atomic_load(p, __ATOMIC_RELAXED, __HIP_MEMORY_SCOPE_AGENT); }
__device__ __forceinline__ unsigned xb_add(unsigned* p, unsigned v) { return __hip_atomic_fetch_add(p, v, __ATOMIC_RELAXED, __HIP_MEMORY_SCOPE_AGENT); }
__device__ __forceinline__ unsigned xb_xcc_id() { return (unsigned)__builtin_amdgcn_s_getreg((3 << 11) | 20) & 0xFu; }
#define XB_SPIN(cond, bar) do { unsigned _sp = 0; while (cond) { __builtin_amdgcn_s_sleep(1); \
    if ((++_sp & 255u) == 0u) { if (xb_ld(&(bar)[XB_TMO])) break; if (_sp > XB_SPIN_CAP) { atomicAdd(&(bar)[XB_TMO], 1u); break; } } } } while (0)
struct XcdBarrier { unsigned* bar; unsigned x; volatile LAS unsigned* st; };
__device__ __forceinline__ XcdBarrier xcd_barrier_post(unsigned* bar, volatile LAS unsigned* st) {
    XcdBarrier b; b.bar = bar; b.x = xb_xcc_id(); b.st = st;
    if (threadIdx.x == 0) (void)xb_add(&bar[XB_XCNT(b.x)], 1u);
    return b;
}
__device__ __forceinline__ void xcd_barrier_complete(unsigned* bar, unsigned x, unsigned& nloc, unsigned& nx) {
    const unsigned G = gridDim.x * gridDim.y * gridDim.z;
    unsigned sum, cnt, mine, sp = 0u;
    for (;;) {
        sum = 0u; cnt = 0u; mine = 0u;
#pragma unroll
        for (unsigned j = 0; j < 16; ++j) { const unsigned c = xb_ld(&bar[XB_XCNT(j)]); sum += c; cnt += (c > 0u) ? 1u : 0u; mine = (j == x) ? c : mine; }
        if (sum == G) break;
        __builtin_amdgcn_s_sleep(1);
        if ((++sp & 255u) == 0u) { if (xb_ld(&bar[XB_TMO])) break; if (sp > XB_SPIN_CAP) { atomicAdd(&bar[XB_TMO], 1u); break; } }
    }
    nloc = mine > 0u ? mine : 1u; nx = cnt > 0u ? cnt : 1u;
}
__device__ __forceinline__ void xcd_barrier(unsigned* bar, unsigned x, volatile LAS unsigned* st) {
    asm volatile("s_waitcnt vmcnt(0)" ::: "memory");
    __syncthreads();
    if (threadIdx.x == 0) {
        __builtin_amdgcn_s_waitcnt(0);
        unsigned nloc = st[0], nx = st[1];
        if (nloc == 0u) { xcd_barrier_complete(bar, x, nloc, nx); st[0] = nloc; st[1] = nx; }
        const unsigned old = xb_add(&bar[XB_XSUB(x)], 1u);
        const unsigned gen = old / nloc;
        if (old + 1u == (gen + 1u) * nloc) {
            __builtin_amdgcn_fence(__ATOMIC_RELEASE, "agent");
            asm volatile("s_waitcnt vmcnt(0)" ::: "memory");
            const unsigned og = xb_add(&bar[XB_TOP], 1u);
            const unsigned tg = og / nx;
            if (og + 1u == (tg + 1u) * nx) xb_add(&bar[XB_TOPGEN], 1u);
            else XB_SPIN(xb_ld(&bar[XB_TOPGEN]) == tg, bar);
            __builtin_amdgcn_fence(__ATOMIC_ACQUIRE, "agent");
            xb_add(&bar[XB_XGEN(x)], 1u);
            asm volatile("s_waitcnt vmcnt(0)" ::: "memory");
        } else {
            XB_SPIN(xb_ld(&bar[XB_XGEN(x)]) == gen, bar);
            __builtin_amdgcn_fence(__ATOMIC_ACQUIRE, "agent");
            asm volatile("s_waitcnt vmcnt(0)" ::: "memory");
        }
    }
    __syncthreads();
}
constexpr size_t WS_BAR = 65536;

struct Args { const void* in[21]; float* out; unsigned char* ws; };
struct Desc { const bf16_t* A; const bf16_t* Bt; const float* ssq_in; float* ssq_out; bf16_t* o16; const float* gfox; const float* gdiff; const float* bfg; const float* subln; const float* pl; const bf16_t* hin;
              int lda, ldb, N, K, mode, flag, sync, fin; float scale, lam, oscale, padf; };
template <class T> __device__ __forceinline__ T* uni_ptr(T* p) { const unsigned long long v = (unsigned long long)(uintptr_t)p;
    const unsigned lo = __builtin_amdgcn_readfirstlane((unsigned)v), hi = __builtin_amdgcn_readfirstlane((unsigned)(v >> 32));
    return (T*)(__attribute__((address_space(1))) T*)(uintptr_t)(((unsigned long long)hi << 32) | lo); }
__device__ __forceinline__ int uni_i(int v) { return __builtin_amdgcn_readfirstlane(v); }
__device__ __forceinline__ float uni_f(float v) { return __uint_as_float(__builtin_amdgcn_readfirstlane(__float_as_uint(v))); }
constexpr int EM_ATTN = 7, NSTEP = 15;
constexpr size_t WS_TAB = 4096;

__global__ void __launch_bounds__(512) fwd_megakernel(Args a) {
    extern __shared__ __attribute__((aligned(16))) unsigned char lds_raw[];
    LAS unsigned char* lds = (LAS unsigned char*)lds_raw;
    cg::grid_group grid = cg::this_grid();
    const int tid = threadIdx.x;

    {
        const int lane = tid & 63, wave = __builtin_amdgcn_readfirstlane(tid >> 6);
        const int G = gridDim.x, bx = blockIdx.x;
        unsigned char* ws = a.ws;
        const float* x = (const float*)a.in[0]; const float* pin = (const float*)a.in[1]; const int* positions = (const int*)a.in[2];
        const float* ffn1_norm = (const float*)a.in[3]; const float* ffn1_wi = (const float*)a.in[4]; const float* ffn1_wo = (const float*)a.in[5];
        const float* mix_norm = (const float*)a.in[6]; const float* w_in = (const float*)a.in[7]; const float* b_forget = (const float*)a.in[8];
        const float* qk_gain_fox = (const float*)a.in[9]; const float* qk_gain_diff = (const float*)a.in[10]; const float* diff_lambda = (const float*)a.in[11];
        const float* diff_subln = (const float*)a.in[12]; const float* w_br = (const float*)a.in[13]; const float* w_o = (const float*)a.in[14];
        const float* ffn2_norm = (const float*)a.in[15]; const float* ffn2_wi = (const float*)a.in[16]; const float* ffn2_wo = (const float*)a.in[17];
        const float* ple_norm = (const float*)a.in[18]; const float* ple_gate_w = (const float*)a.in[19]; const float* ple_proj_w = (const float*)a.in[20];
        float* out = a.out;
        unsigned* ctl = (unsigned*)(ws + WS_CTL);
        float* SS = (float*)(ws + WS_SS);
        float* cosT = (float*)(ws + WS_COS); float* sinT = (float*)(ws + WS_SIN);
        bf16_t* Wb = (bf16_t*)(ws + WS_W);
        bf16_t* HB = (bf16_t*)(ws + WS_HB); bf16_t* BIG = (bf16_t*)(ws + WS_BIG); bf16_t* GS = (bf16_t*)(ws + WS_GS); bf16_t* AO = (bf16_t*)(ws + WS_AO); bf16_t* PB = (bf16_t*)(ws + WS_PB);
        bf16_t* M16 = (bf16_t*)(ws + WS_BIG + 128 * MiB);
        const int gw = bx * 8 + wave, NGW = G * 8; const int gt = bx * 512 + tid, NGT = G * 512;
        if (gt < 16) ctl[gt] = 0u;
        if (gt < XCD_BAR_WORDS) ((unsigned*)(ws + WS_BAR))[gt] = 0u;
        if (tid < 2) ((volatile LAS unsigned*)(lds + att::LMISC + 128))[tid] = 0u;
        if (bx == 0 && wave >= 4) {
            const int l = wave - 4; const float* lf = diff_lambda + l * 256;
            const float s1 = wave_sum(lf[lane] * lf[64 + lane]), s2 = wave_sum(lf[128 + lane] * lf[192 + lane]);
            const float lam_init = 0.8f - 0.6f * expf(-0.3f * (float)l);
            if (lane == 0) ((float*)ctl)[16 + l] = expf(s1) - expf(s2) + lam_init;
        }
        if (bx == 0 && tid < NLAYER * NSTEP) {
            Desc* tab = (Desc*)(ws + WS_TAB);
            const int l = tid / NSTEP, st = tid % NSTEP;
            {
                const float lam_init = 0.8f - 0.6f * expf(-0.3f * (float)l);
                bf16_t* WL = Wb + (size_t)l * LAYER_W_ELEMS; float* SSl = SS + (size_t)(4 * l) * MTOK;
                {
                    Desc* d = tab + l * NSTEP + st;
                    const bf16_t* A = HB; const bf16_t* Bt = WL; const float* ssq_in = SSl; float* ssq_out = SSl; bf16_t* o16 = GS;
                    int lda = DM, ldb = DM, N = DM, K = DM, mode = 0, flag = 0, sync = 1; float scale = 1.f;
                    switch (st) {
                        case 0: A = AO; Bt = WL + OW_1I; N = 2 * DFF; mode = pg8::EM_SWIGLU; ssq_in = SSl; o16 = BIG; break;
                        case 1: A = BIG; lda = DFF; Bt = WL + OW_1O; ldb = DFF; K = DFF; mode = pg8::EM_RES; scale = 0.5f; o16 = HB; ssq_out = SSl + MTOK; break;
                        case 2: A = HB; Bt = WL + OW_IN; N = NIN; mode = pg8::EM_QKV; ssq_in = SSl + MTOK; o16 = BIG; break;
                        case 3: mode = EM_ATTN; break;
                        case 4: case 6: case 8: A = HB; Bt = WL + OW_G + (size_t)((st - 4) >> 1) * DM * DM; mode = pg8::EM_GATE; ssq_in = SSl + MTOK; o16 = GS; sync = 0; break;
                        case 5: A = AO; Bt = WL + OW_BR; K = 256; ldb = 256; mode = pg8::EM_MERGE; flag = 0; o16 = M16; sync = 0; break;
                        case 7: A = AO + 256; Bt = WL + OW_BR + 262144; K = 256; ldb = 256; mode = pg8::EM_MERGE; flag = 1; o16 = M16; sync = 0; break;
                        case 9: A = AO + 512; Bt = WL + OW_BR + 524288; K = 512; ldb = 512; mode = pg8::EM_MERGE; flag = 2; o16 = M16; break;
                        case 10: A = M16; Bt = WL + OW_O; mode = pg8::EM_RES; scale = 1.0f; o16 = HB; ssq_out = SSl + 2 * MTOK; break;
                        case 11: A = HB; Bt = WL + OW_2I; N = 2 * DFF; mode = pg8::EM_SWIGLU; ssq_in = SSl + 2 * MTOK; o16 = BIG; break;
                        case 12: A = BIG; lda = DFF; Bt = WL + OW_2O; ldb = DFF; K = DFF; mode = pg8::EM_RES; scale = 0.5f; o16 = HB; ssq_out = SSl + 3 * MTOK; break;
                        case 13: A = PB; lda = PDIM; Bt = WL + OW_PP; ldb = PDIM; K = PDIM; mode = pg8::EM_STORE; o16 = GS; sync = 0; break;
                        default: A = HB; Bt = WL + OW_PG; mode = pg8::EM_PLE; ssq_in = SSl + 3 * MTOK; ssq_out = SSl + 4 * MTOK; o16 = AO; break;
                    }
                    d->A = A; d->Bt = Bt; d->ssq_in = ssq_in; d->ssq_out = ssq_out; d->o16 = o16;
                    d->gfox = qk_gain_fox + l * 128; d->gdiff = qk_gain_diff + l * 128; d->bfg = b_forget + l * 4; d->subln = diff_subln + l * 128; d->pl = pin + (size_t)l * MTOK * PDIM;
                    d->lda = lda; d->ldb = ldb; d->N = N; d->K = K; d->mode = mode; d->flag = flag; d->sync = sync; d->fin = (l == NLAYER - 1 && st == NSTEP - 1) ? 1 : 0;
                    d->hin = (st == 1) ? AO : HB;
                    d->scale = scale; d->lam = 0.f; d->oscale = 1.0f - lam_init; d->padf = 0.f;
                }
            }
        }
        for (int i = gt; i < 16 * MTOK; i += NGT) SS[MTOK + i] = 0.f;
        for (int i = gt; i < MTOK * 8; i += NGT) {
            const int m = i >> 3, f = i & 7; const float inv = powf(500000.0f, -(float)f * 0.125f);
            const float ang = (float)positions[m] * inv; cosT[i] = cosf(ang); sinT[i] = sinf(ang);
        }
        LAS float* scr = (LAS float*)(lds + wave * 16384);
        {
            constexpr int IT_WI = 16 * 176, IT_WO = 44 * 32, IT_IN = 16 * 104, IT_SQ = 16 * 32, IT_B4 = 4 * 32, IT_B8 = 8 * 32, IT_PP = 4 * 32;
            constexpr int IT_LAYER = 2 * IT_WI + 2 * IT_WO + IT_IN + 5 * IT_SQ + 2 * IT_B4 + IT_B8 + IT_PP;
#pragma unroll 1
            for (int gi = gw; gi < NLAYER * IT_LAYER; gi += NGW) {
                const int l = gi / IT_LAYER; int r = gi - l * IT_LAYER;
                bf16_t* WL = Wb + (size_t)l * LAYER_W_ELEMS;
                MatDesc d; d.gain = nullptr; d.ldw = DM; d.K = DM; d.Np = DM; d.kind = 0;
                if (r < IT_WI) { d.src = ffn1_wi + (size_t)l * DM * 2 * DFF; d.ldw = 2 * DFF; d.Np = 2 * DFF; d.kind = 1; d.gain = ffn1_norm + l * DM; d.dst = WL + OW_1I; }
                else if ((r -= IT_WI) < IT_WI) { d.src = ffn2_wi + (size_t)l * DM * 2 * DFF; d.ldw = 2 * DFF; d.Np = 2 * DFF; d.kind = 1; d.gain = ffn2_norm + l * DM; d.dst = WL + OW_2I; }
                else if ((r -= IT_WI) < IT_WO) { d.src = ffn1_wo + (size_t)l * DFF * DM; d.K = DFF; d.dst = WL + OW_1O; }
                else if ((r -= IT_WO) < IT_WO) { d.src = ffn2_wo + (size_t)l * DFF * DM; d.K = DFF; d.dst = WL + OW_2O; }
                else if ((r -= IT_WO) < IT_IN) { d.src = w_in + (size_t)l * DM * INCOLS; d.ldw = INCOLS; d.Np = NIN; d.kind = 2; d.gain = mix_norm + l * DM; d.dst = WL + OW_IN; }
                else if ((r -= IT_IN) < 3 * IT_SQ) { const int gidx = r / IT_SQ; r -= gidx * IT_SQ; d.src = w_in + (size_t)l * DM * INCOLS + 3076 + 1024 * gidx; d.ldw = INCOLS; d.gain = mix_norm + l * DM; d.dst = WL + OW_G + (size_t)gidx * DM * DM; }
                else if ((r -= 3 * IT_SQ) < IT_SQ) { d.src = w_o + (size_t)l * DM * DM; d.dst = WL + OW_O; }
                else if ((r -= IT_SQ) < IT_SQ) { d.src = ple_gate_w + (size_t)l * DM * DM; d.gain = ple_norm + l * DM; d.dst = WL + OW_PG; }
                else if ((r -= IT_SQ) < IT_B4) { d.src = w_br + (size_t)l * DM * DM; d.K = 256; d.dst = WL + OW_BR; }
                else if ((r -= IT_B4) < IT_B4) { d.src = w_br + (size_t)l * DM * DM + 256 * DM; d.K = 256; d.dst = WL + OW_BR + 262144; }
                else if ((r -= IT_B4) < IT_B8) { d.src = w_br + (size_t)l * DM * DM + 512 * DM; d.K = 512; d.dst = WL + OW_BR + 524288; }
                else { r -= IT_B8; d.src = ple_proj_w + (size_t)l * PDIM * DM; d.K = PDIM; d.dst = WL + OW_PP; }
                xpose_item(d, r, scr, lane);
            }
        }
        for (int m = gw; m < MTOK; m += NGW) {
            const f32x4* xr = (const f32x4*)(x + (size_t)m * DM) + lane;
            u32x2* hb = (u32x2*)(AO + (size_t)m * DM) + lane; u32x2* lb = (u32x2*)((bf16_t*)(ws + WS_LO) + (size_t)m * DM) + lane;
            float s2 = 0.f;
#pragma unroll
            for (int j = 0; j < 4; ++j) { const f32x4 v = xr[64 * j]; s2 += dot4(v); u32x2 w; w.x = cvtpk(v[0], v[1]); w.y = cvtpk(v[2], v[3]); hb[64 * j] = w;
                f32x4 g; g[0] = __uint_as_float(w.x << 16); g[1] = __uint_as_float(w.x & 0xffff0000u); g[2] = __uint_as_float(w.y << 16); g[3] = __uint_as_float(w.y & 0xffff0000u);
                u32x2 wl; wl.x = cvtpk(v[0] - g[0], v[1] - g[1]); wl.y = cvtpk(v[2] - g[2], v[3] - g[3]); lb[64 * j] = wl; }
            s2 = wave_sum(s2);
            if (lane == 0) SS[m] = s2;
        }
    }
    grid.sync();
    const unsigned xcc = xcd_barrier_post((unsigned*)(a.ws + WS_BAR), (volatile LAS unsigned*)(lds + att::LMISC + 128)).x;
#define GRID_BAR() xcd_barrier((unsigned*)(ws + WS_BAR), xcc, (volatile LAS unsigned*)(lds + att::LMISC + 128))

#pragma unroll 1
    for (int ls = 0; ls < NLAYER * NSTEP; ++ls) {
        unsigned char* ws = a.ws; asm volatile("" : "+s"(ws) :: "memory"); ws = (unsigned char*)(__attribute__((address_space(1))) unsigned char*)ws;
        float* out = a.out; asm volatile("" : "+s"(out)); out = (float*)(__attribute__((address_space(1))) float*)out;
        const Desc* dp = (const Desc*)(ws + WS_TAB) + ls;
        const int mode = uni_i(dp->mode);
        const int G = gridDim.x, bx = blockIdx.x;
        if (mode == EM_ATTN) {
            unsigned* ctl = (unsigned*)(ws + WS_CTL) + ls / NSTEP;
            const GAS bf16_t* QKVb = (const GAS bf16_t*)(ws + WS_BIG); GAS bf16_t* AOb = (GAS bf16_t*)(ws + WS_AO); const GAS float* logfB = (const GAS float*)(ws + WS_LOGF);
            const float lam = uni_f(((const float*)(ws + WS_CTL))[16 + ls / NSTEP]), oscale = uni_f(dp->oscale); const GAS float* subln = (const GAS float*)uni_ptr(dp->subln); const GAS float* gfoxp = (const GAS float*)uni_ptr(dp->gfox);
            LAS int* qslot = (LAS int*)(lds + att::LMISC);
            bool nomaxB, nomaxC;
            {
                const GAS float* gd = (const GAS float*)uni_ptr(dp->gdiff); const int ln = tid & 63;
                float a = fabsf(gfoxp[ln]), bq = fabsf(gfoxp[64 + ln]), c = fabsf(gd[ln]), d = fabsf(gd[64 + ln]);
#pragma unroll
                for (int o = 1; o < 64; o <<= 1) { a = fmaxf(a, __shfl_xor(a, o)); bq = fmaxf(bq, __shfl_xor(bq, o)); c = fmaxf(c, __shfl_xor(c, o)); d = fmaxf(d, __shfl_xor(d, o)); }
                nomaxB = __builtin_amdgcn_readfirstlane((64.0f * C2 * a * bq * 1.03f + 1.0f) <= 40.0f ? 1 : 0) != 0;
                nomaxC = __builtin_amdgcn_readfirstlane((64.0f * C2 * c * d * 1.03f + 1.0f) <= 40.0f ? 1 : 0) != 0;
            }
#ifndef ATT_REPS
#define ATT_REPS 1
#endif
            for (int rep = 0; rep < ATT_REPS; ++rep)
            for (;;) {
                if (tid == 0) qslot[0] = (int)atomicAdd(ctl + 4 * rep, 1u);
                __syncthreads();
                const int idx = qslot[0];
                __syncthreads();
                if (idx >= 1536) break;
                const int kind = idx >> 9, r = idx & 511, qb = 15 - (r >> 5), bh = r & 31, b = bh >> 2, hh = bh & 3;
                if (kind == 0) { if (nomaxC) att::attn_unit<2, true>(b, hh, qb, QKVb, AOb, logfB, subln, lam, oscale, lds); else att::attn_unit<2, false>(b, hh, qb, QKVb, AOb, logfB, subln, lam, oscale, lds); }
                else if (kind == 1) { if (nomaxB) att::attn_unit<1, true>(b, hh, qb, QKVb, AOb, logfB, gfoxp, 0.f, 1.f, lds); else att::attn_unit<1, false>(b, hh, qb, QKVb, AOb, logfB, gfoxp, 0.f, 1.f, lds); }
                else att::attn_unit<0>(b, hh, qb, QKVb, AOb, logfB, nullptr, 0.f, 1.f, lds);
            }
            GRID_BAR();
            continue;
        }
        if (ls % NSTEP == 11) {
            const float* pl = uni_ptr(dp->pl); bf16_t* PB = (bf16_t*)(ws + WS_PB);
            for (size_t i = (size_t)bx * 512 + tid; i < (size_t)MTOK * PDIM / 8; i += (size_t)G * 512) {
                const f32x4 v0 = *(const f32x4*)(pl + i * 8), v1 = *(const f32x4*)(pl + i * 8 + 4); *(u32x4*)(PB + i * 8) = pack8(v0, v1); }
        }
        pg8::Gemm g; pg8::Epi e;
        g.A = uni_ptr(dp->A); g.Bt = uni_ptr(dp->Bt); g.lda = uni_i(dp->lda); g.ldb = uni_i(dp->ldb); g.M = MTOK; g.N = uni_i(dp->N); g.K = uni_i(dp->K);
        e.mode = mode; e.flag = uni_i(dp->flag); e.scale = uni_f(dp->scale); e.ssq_in = (const GAS float*)uni_ptr(dp->ssq_in); e.ssq_out = (GAS float*)uni_ptr(dp->ssq_out); e.h = (GAS float*)out; e.o16 = (GAS bf16_t*)uni_ptr(dp->o16);
        e.mf = (GAS float*)(ws + WS_BIG); e.g16 = (const GAS bf16_t*)(ws + WS_GS);
        e.hin = (const GAS bf16_t*)uni_ptr(dp->hin); e.lo = (GAS bf16_t*)(ws + WS_LO); e.fin = uni_i(dp->fin);
        e.gfox = (const GAS float*)uni_ptr(dp->gfox); e.gdiff = (const GAS float*)uni_ptr(dp->gdiff); e.cosT = (const GAS float*)(ws + WS_COS); e.sinT = (const GAS float*)(ws + WS_SIN); e.bfg = (const GAS float*)uni_ptr(dp->bfg); e.logf = (GAS float*)(ws + WS_LOGF);
        const int do_sync = uni_i(dp->sync);
        pg8::StaticOrder S; S.init(g.M, g.N, G, bx);
        pg8::gemm_phase(lds, g, S, e);
#ifdef REP_MASK
        if ((REP_MASK >> (ls % NSTEP)) & 1) pg8::gemm_phase(lds, g, S, e);
#endif
        if (do_sync) GRID_BAR();
#ifdef SYNC_REPS
        if (do_sync) GRID_BAR();
#endif
    }
}

extern "C" void kernel_launch(void* const* d_in, const int* in_sizes, int n_in, void* d_out, int out_size, void* d_ws, size_t ws_size, hipStream_t stream) {
    static int grid = 0;
    if (grid == 0) {
        if (n_in != 21 || out_size != MTOK * DM || ws_size < WS_END) { fprintf(stderr, "kernel_launch: unexpected shapes: n_in %d out %d ws %zu (need %zu)\n", n_in, out_size, ws_size, (size_t)WS_END); grid = -1; return; }
        int dev = 0, cus = 0, per_cu = 0;
        hipGetDevice(&dev);
        hipDeviceGetAttribute(&cus, hipDeviceAttributeMultiprocessorCount, dev);
        hipFuncSetAttribute((const void*)fwd_megakernel, hipFuncAttributeMaxDynamicSharedMemorySize, LDS_BYTES);
        hipOccupancyMaxActiveBlocksPerMultiprocessor(&per_cu, (const void*)fwd_megakernel, 512, LDS_BYTES);
        if (per_cu < 1) { fprintf(stderr, "kernel_launch: occupancy query says %d blocks per CU\n", per_cu); per_cu = 1; }
        (void)hipGetLastError();
        grid = cus * per_cu;
    }
    if (grid < 0) return;
    Args a{};
    for (int i = 0; i < 21; ++i) a.in[i] = d_in[i];
    a.out = (float*)d_out; a.ws = (unsigned char*)d_ws;
    void* args[] = {&a};
    hipError_t e = hipLaunchCooperativeKernel((const void*)fwd_megakernel, dim3(grid), dim3(512), args, LDS_BYTES, stream);
    if (e != hipSuccess) fprintf(stderr, "cooperative launch failed: %s (grid %d)\n", hipGetErrorString(e), grid);
}
```
